# Optimizing an MI355X kernel written in HIP

```python
import jax, jax.numpy as jnp
from jax import lax
import numpy as np

D_MODEL = 1024
BATCH = 8
SEQ = 2048
DEPTH = 1
DEC_BATCH = 128
DEC_SEQ = 4
PAST_LEN = 16384
PAGE_SIZE = 128

PLE_DIM = 256
D_SG = D_MODEL
SG_HEADS = 4
SG_HEAD_DIM = D_SG // SG_HEADS
CHUNK = 128
D_LRU = D_MODEL
LRU_BLOCKS = 8
LRU_BLOCK_DIM = D_LRU // LRU_BLOCKS
CONV_WIDTH = 4
LRU_C = 8.0
EPS = 1e-6
D_IN = 3 * D_SG + 2 * D_LRU

kernel_name = 'hybrid_sgmlp_rglru_decoder_step'


def rms_norm(x, g):
    xf = x.astype(jnp.float32)
    var = jnp.mean(xf * xf, axis=-1, keepdims=True)
    return (xf * lax.rsqrt(var + EPS) * g.astype(jnp.float32)).astype(x.dtype)


def chunk_spatial_mix(z, w_s, b_s):
    B, T = z.shape[0], z.shape[1]
    n_chunks = -(-T // CHUNK)
    pad = n_chunks * CHUNK - T
    zp = jnp.pad(z, ((0, 0), (0, pad), (0, 0), (0, 0)))
    zc = zp.reshape(B, n_chunks, CHUNK, SG_HEADS, SG_HEAD_DIM)
    mask = jnp.tril(jnp.ones((CHUNK, CHUNK), dtype=bool))
    w = jnp.where(mask[None], w_s, jnp.zeros_like(w_s)).astype(z.dtype)
    s = jnp.einsum('hts,bnshd->bnthd', w, zc) + b_s.T.astype(z.dtype)[None, None, :, :, None]
    return s.reshape(B, n_chunks * CHUNK, SG_HEADS, SG_HEAD_DIM)[:, :T]


def causal_conv(xb, buf, w, b):
    T = xb.shape[1]
    xp = jnp.concatenate([buf.astype(xb.dtype), xb], axis=1)
    y = b.astype(xb.dtype)
    for k in range(CONV_WIDTH):
        y = y + w[k].astype(xb.dtype) * xp[:, k:k + T]
    return y, xp[:, -(CONV_WIDTH - 1):]


def rg_lru(xc, h0, wa, ba, wx, bx, lam):
    B, T = xc.shape[0], xc.shape[1]
    xb = xc.reshape(B, T, LRU_BLOCKS, LRU_BLOCK_DIM)
    r = jax.nn.sigmoid(jnp.einsum('btnc,ncd->btnd', xb, wa).reshape(B, T, D_LRU) + ba)
    i = jax.nn.sigmoid(jnp.einsum('btnc,ncd->btnd', xb, wx).reshape(B, T, D_LRU) + bx)
    log_a = (-LRU_C * jax.nn.softplus(-lam.astype(jnp.float32))) * r.astype(jnp.float32)
    a = jnp.exp(log_a)
    mult = jnp.sqrt(-jnp.expm1(2.0 * log_a))
    bterm = mult * (i * xc).astype(jnp.float32)

    def combine(c1, c2):
        a1, b1 = c1
        a2, b2 = c2
        return a1 * a2, a2 * b1 + b2

    a_cum, h_zero = lax.associative_scan(combine, (a, bterm), axis=1)
    h = h_zero + a_cum * h0.astype(jnp.float32)[:, None]
    return h.astype(xc.dtype), h[:, -1].astype(h0.dtype)


def mixer_layer(x, p_l, conv_buf, h0, norm_pre, w_in, sg_norm, sg_w, sg_b, conv_w, conv_b,
                lru_wa, lru_ba, lru_wx, lru_bx, lru_lambda, w_branch_sg, w_branch_lru,
                w_merge, b_merge, w_out, norm_post, w_ple, w_ple_gate, b_ple_gate):
    B, T = x.shape[0], x.shape[1]
    h = rms_norm(x, norm_pre)
    proj = h @ w_in
    u, v, g_sg, x_lru, g_lru = jnp.split(
        proj, [D_SG, 2 * D_SG, 3 * D_SG, 3 * D_SG + D_LRU], axis=-1)
    z = rms_norm(v.reshape(B, T, SG_HEADS, SG_HEAD_DIM), sg_norm.reshape(SG_HEADS, SG_HEAD_DIM))
    s = chunk_spatial_mix(z, sg_w, sg_b).reshape(B, T, D_SG)
    y_sg = u * s * jax.nn.silu(g_sg)
    xc, new_conv = causal_conv(x_lru, conv_buf, conv_w, conv_b)
    hseq, new_h = rg_lru(xc, h0, lru_wa, lru_ba, lru_wx, lru_bx, lru_lambda)
    y_lru = hseq * jax.nn.silu(g_lru)
    g_a, g_b = jnp.split(jax.nn.sigmoid(h @ w_merge + b_merge), 2, axis=-1)
    merged = g_a * (y_sg @ w_branch_sg) + g_b * (y_lru @ w_branch_lru)
    x = x + rms_norm(merged @ w_out, norm_post)
    x = x + jax.nn.sigmoid(x @ w_ple_gate + b_ple_gate) * (p_l @ w_ple)
    return x, new_conv, new_h, z.reshape(B, T, D_SG)


def setup_inputs(seed: int = 0) -> dict:
    key = jax.random.key(seed)
    ks = jax.random.split(key, 32)
    f32 = jnp.float32

    def nrm(k, shape, scale):
        return jax.random.normal(k, shape, f32) * scale

    a0 = jax.random.uniform(ks[20], (DEPTH, D_LRU), f32, 0.9, 0.999)
    s0 = a0 ** (1.0 / LRU_C)
    lru_lambda = jnp.log(s0) - jnp.log1p(-s0)
    return {
        'x_prompt': nrm(ks[0], (BATCH, SEQ, D_MODEL), 1.0),
        'x_sample': nrm(ks[1], (DEC_BATCH, DEC_SEQ, D_MODEL), 1.0),
        'p_prompt': nrm(ks[2], (DEPTH, BATCH, SEQ, PLE_DIM), 1.0),
        'p_sample': nrm(ks[3], (DEPTH, DEC_BATCH, DEC_SEQ, PLE_DIM), 1.0),
        'state_conv': nrm(ks[4], (DEPTH, DEC_BATCH, CONV_WIDTH - 1, D_LRU), 1.0),
        'state_lru': nrm(ks[5], (DEPTH, DEC_BATCH, D_LRU), 0.5),
        'norm_pre': 1.0 + nrm(ks[6], (DEPTH, D_MODEL), 0.05),
        'w_in': nrm(ks[7], (DEPTH, D_MODEL, D_IN), D_MODEL ** -0.5),
        'sg_norm': 1.0 + nrm(ks[8], (DEPTH, D_SG), 0.05),
        'sg_w': nrm(ks[9], (DEPTH, SG_HEADS, CHUNK, CHUNK), 0.5 * CHUNK ** -0.5),
        'sg_b': 1.0 + nrm(ks[10], (DEPTH, SG_HEADS, CHUNK), 0.05),
        'conv_w': nrm(ks[11], (DEPTH, CONV_WIDTH, D_LRU), CONV_WIDTH ** -0.5),
        'conv_b': nrm(ks[12], (DEPTH, D_LRU), 0.02),
        'lru_wa': nrm(ks[13], (DEPTH, LRU_BLOCKS, LRU_BLOCK_DIM, LRU_BLOCK_DIM), LRU_BLOCK_DIM ** -0.5),
        'lru_ba': nrm(ks[14], (DEPTH, D_LRU), 0.02),
        'lru_wx': nrm(ks[15], (DEPTH, LRU_BLOCKS, LRU_BLOCK_DIM, LRU_BLOCK_DIM), LRU_BLOCK_DIM ** -0.5),
        'lru_bx': nrm(ks[16], (DEPTH, D_LRU), 0.02),
        'lru_lambda': lru_lambda,
        'w_branch_sg': nrm(ks[17], (DEPTH, D_SG, D_MODEL), D_SG ** -0.5),
        'w_branch_lru': nrm(ks[18], (DEPTH, D_LRU, D_MODEL), D_LRU ** -0.5),
        'w_merge': nrm(ks[19], (DEPTH, D_MODEL, 2 * D_MODEL), D_MODEL ** -0.5),
        'b_merge': nrm(ks[21], (DEPTH, 2 * D_MODEL), 0.02),
        'w_out': nrm(ks[22], (DEPTH, D_MODEL, D_MODEL), D_MODEL ** -0.5),
        'norm_post': 1.0 + nrm(ks[23], (DEPTH, D_MODEL), 0.05),
        'w_ple': nrm(ks[24], (DEPTH, PLE_DIM, D_MODEL), PLE_DIM ** -0.5),
        'w_ple_gate': nrm(ks[25], (DEPTH, D_MODEL, D_MODEL), D_MODEL ** -0.5),
        'b_ple_gate': nrm(ks[26], (DEPTH, D_MODEL), 0.02),
    }


def reference(x_prompt, x_sample, p_prompt, p_sample, state_conv, state_lru,
              norm_pre, w_in, sg_norm, sg_w, sg_b, conv_w, conv_b,
              lru_wa, lru_ba, lru_wx, lru_bx, lru_lambda, w_branch_sg, w_branch_lru,
              w_merge, b_merge, w_out, norm_post, w_ple, w_ple_gate, b_ple_gate):
    xp = x_prompt
    xs = x_sample
    conv_p, lru_p, conv_s, lru_s, chunk_s = [], [], [], [], []
    for l in range(DEPTH):
        lw = (norm_pre[l], w_in[l], sg_norm[l], sg_w[l], sg_b[l], conv_w[l], conv_b[l],
              lru_wa[l], lru_ba[l], lru_wx[l], lru_bx[l], lru_lambda[l],
              w_branch_sg[l], w_branch_lru[l], w_merge[l], b_merge[l], w_out[l],
              norm_post[l], w_ple[l], w_ple_gate[l], b_ple_gate[l])
        buf0 = jnp.zeros((xp.shape[0], CONV_WIDTH - 1, D_LRU), xp.dtype)
        h00 = jnp.zeros((xp.shape[0], D_LRU), state_lru.dtype)
        xp, cp, hp, _ = mixer_layer(xp, p_prompt[l], buf0, h00, *lw)
        xs, cs, hs, zs = mixer_layer(xs, p_sample[l], state_conv[l], state_lru[l], *lw)
        conv_p.append(cp)
        lru_p.append(hp)
        conv_s.append(cs)
        lru_s.append(hs)
        chunk_s.append(zs)
    conv_prompt = jnp.stack(conv_p)
    lru_prompt = jnp.stack(lru_p)
    conv_sample = jnp.stack(conv_s)
    lru_sample = jnp.stack(lru_s)
    chunk_v_sample = jnp.stack(chunk_s)
    return (xp, xs, conv_prompt, lru_prompt, conv_sample, lru_sample, chunk_v_sample)
```

```cpp
#include <hip/hip_runtime.h>
#include <cstdio>
#include <cstdint>

#define LAS __attribute__((address_space(3)))
#define GAS __attribute__((address_space(1)))
typedef unsigned short bf16_t;
typedef short bf16x8 __attribute__((ext_vector_type(8)));
typedef short s16x4 __attribute__((ext_vector_type(4)));
typedef float f32x4 __attribute__((ext_vector_type(4)));
typedef float f32x2 __attribute__((ext_vector_type(2)));
typedef unsigned u32x4 __attribute__((ext_vector_type(4)));
typedef unsigned u32x2 __attribute__((ext_vector_type(2)));
typedef GAS unsigned gu32;

constexpr int D = 1024, MP = 16384, MS = 512, M = MP + MS, SEQ = 2048, NBATCH = 8, DBATCH = 128, PLE = 256;
constexpr int NIN = 7168;
constexpr float EPS = 1e-6f;
constexpr size_t O_Y = 0, O_CONVP = (size_t)M * D, O_LRUP = O_CONVP + 8 * 3 * 1024, O_CONVS = O_LRUP + 8 * 1024, O_LRUS = O_CONVS + 128 * 3 * 1024, O_CHV = O_LRUS + 128 * 1024, O_END = O_CHV + 128 * 4 * 1024;

constexpr size_t MiB = 1u << 20;
constexpr size_t WS_CTL = 0, CTL_ZERO_BYTES = 256 * 1024;
constexpr size_t WS_WIN = 1 * MiB, WS_WBR = 15 * MiB, WS_WOUT = 19 * MiB, WS_WPG = 21 * MiB, WS_WPLE = 23 * MiB, WS_LWA = 23 * MiB + 512 * 1024, WS_LWX = WS_LWA + 256 * 1024, WS_SGW = 24 * MiB;
constexpr size_t WS_PB = 25 * MiB;
constexpr size_t RSZ = 33 * MiB;
constexpr size_t WS_R0 = 36 * MiB, WS_R1 = WS_R0 + RSZ, WS_R2 = WS_R1 + RSZ, WS_R3 = WS_R2 + RSZ, WS_R4 = WS_R3 + RSZ, WS_R5 = WS_R4 + RSZ, WS_END = WS_R5 + RSZ;
static_assert(WS_END <= 256 * MiB, "ws map");
static_assert((size_t)M * D * 2 <= RSZ, "region size");
constexpr int CW_BAR = 1024;

constexpr int RING_BYTES = 131072, EPI_OFF = RING_BYTES, EPI_BYTES = 4096, MISC_OFF = EPI_OFF + EPI_BYTES, LDS_BYTES = 147456;
constexpr int NWAVES = 8;

__device__ __forceinline__ unsigned cvt_pk_bf16(float lo, float hi) { unsigned r; asm volatile("v_cvt_pk_bf16_f32 %0, %1, %2" : "=v"(r) : "v"(lo), "v"(hi)); return r; }
__device__ __forceinline__ float bf_lo(unsigned w) { return __builtin_bit_cast(float, w << 16); }
__device__ __forceinline__ float bf_hi(unsigned w) { return __builtin_bit_cast(float, w & 0xffff0000u); }
__device__ __forceinline__ float bf2f(bf16_t h) { return __builtin_bit_cast(float, (unsigned)h << 16); }
__device__ __forceinline__ float sigm(float x) { return __builtin_amdgcn_rcpf(1.f + __builtin_amdgcn_exp2f(-1.44269504089f * x)); }
__device__ __forceinline__ float wave_sum(float v) {
#pragma unroll
    for (int o = 1; o < 64; o <<= 1) v += __shfl_xor(v, o);
    return v;
}
#define LDS_WAIT() asm volatile("s_waitcnt lgkmcnt(0)" ::: "memory")
#define VM_WAIT() asm volatile("s_waitcnt vmcnt(0)" ::: "memory")

namespace pg8 {
constexpr int BM = 256, BK = 64, HALF = 128, HTB = HALF * BK * 2, NXCD = 8, WGM = 8;
__host__ __device__ __forceinline__ int lds_byte(int r, int c) { const int st = (r >> 4) * 2 + (c >> 5), rr = r & 15, cc = c & 31, ob = rr * 64 + cc * 2; return st * 1024 + (ob ^ (((ob >> 9) & 1) << 5)); }
__host__ __device__ __forceinline__ void stage_rc(int b, int& R, int& C) { const int st = b / 1024, sb = b % 1024, swz = sb ^ (((sb >> 9) & 1) << 5); R = (st >> 1) * 16 + swz / 64; C = (st & 1) * 32 + (swz % 64) / 2; }
__host__ __device__ __forceinline__ int perm32(int rho) { const int n = rho >> 4, i = rho & 15; return 8 * (i >> 2) + 4 * n + (i & 3); }
struct Unit { int pm, pn; };
struct Gemm { const bf16_t* A; const bf16_t* A2; const bf16_t* Bt; int lda, ldb, nt, ks; };
struct StaticOrder {
    int nM, nN, nwg, G, c;
    __device__ void init(int M_, int N_, int G_, int c_) { nM = M_ / BM; nN = N_ / BM; nwg = nM * nN; G = G_; c = c_; }
    __device__ bool next(int i, Unit& u) const {
        const long L = (long)i * G + c; if (L >= nwg) return false;
        int wgid = (int)L; { const int q = nwg / NXCD, r = nwg % NXCD, xcd = wgid % NXCD, off = wgid / NXCD; wgid = (xcd < r ? xcd * (q + 1) : r * (q + 1) + (xcd - r) * q) + off; }
        const int nig = WGM * nN, gid = wgid / nig, fm = gid * WGM, gsz = (nM - fm) < WGM ? (nM - fm) : WGM;
        u.pm = fm + ((wgid % nig) % gsz); u.pn = (wgid % nig) / gsz; return true;
    }
};
__device__ __forceinline__ const char* a_tile(const Gemm& g, int pm, int kt) {
    const bool first = kt < g.ks; const bf16_t* base = first ? g.A : g.A2; const int kk = first ? kt : kt - g.ks;
    return (const char*)base + ((size_t)pm * BM * g.lda + (size_t)kk * BK) * 2;
}
__device__ __forceinline__ const char* b_tile(const Gemm& g, int pn, int kt) { return (const char*)g.Bt + ((size_t)pn * BM * g.ldb + (size_t)kt * BK) * 2; }

template <class Epi, bool ALIGN_EPI>
__device__ __forceinline__ void gemm_phase(LAS unsigned char* lds, LAS unsigned char* epi_lds, const Gemm g, const StaticOrder& S, const Epi& E) {
    int tid_ = threadIdx.x; asm volatile("" : "+v"(tid_));
    const int tid = tid_, wid = __builtin_amdgcn_readfirstlane(tid >> 6), lane = tid & 63, wr = wid >> 2, wc = wid & 3, fr = lane & 15, fq = lane >> 4;
    const int nt = g.nt;
    unsigned voffA[2], voffB[2];
#pragma unroll
    for (int i = 0; i < 2; ++i) { int R, C; stage_rc(tid * 16 + i * 8192, R, C); const int Rb = Epi::PERM ? ((R & ~31) + perm32(R & 31)) : R;
        voffA[i] = (unsigned)(R * g.lda + C) * 2u; voffB[i] = (unsigned)(Rb * g.ldb + C) * 2u; }
    const size_t hstepA = (size_t)HALF * g.lda * 2, hstepB = (size_t)HALF * g.ldb * 2;
    const unsigned ldsw = (unsigned)wid * 1024u;
    const int aoff = lds_byte(wr * 64 + fr, fq * 8), boff = lds_byte(wc * 32 + fr, fq * 8);
#define PG8_SA(b, h) (((b) * 2 + (h)) * HTB)
#define PG8_SB(b, h) ((4 + (b) * 2 + (h)) * HTB)
#define PG8_STAGE(bufoff, gbase, voff) do { _Pragma("unroll") for (int _i = 0; _i < 2; ++_i) \
        __builtin_amdgcn_global_load_lds((const unsigned*)((const char*)(gbase) + (voff)[_i]), (LAS unsigned*)(lds + (bufoff) + ldsw + _i * 8192), 16, 0, 0); } while (0)
#define PG8_LDA(dst, b, h) do { _Pragma("unroll") for (int m = 0; m < 4; ++m) _Pragma("unroll") for (int k = 0; k < 2; ++k) dst[m][k] = *(const LAS bf16x8*)(lds + PG8_SA(b, h) + aoff + m * 2048 + k * 1024); } while (0)
#define PG8_LDB(dst, b, h) do { _Pragma("unroll") for (int n = 0; n < 2; ++n) _Pragma("unroll") for (int k = 0; k < 2; ++k) dst[n][k] = *(const LAS bf16x8*)(lds + PG8_SB(b, h) + boff + n * 2048 + k * 1024); } while (0)
#define PG8_MMA(ai, bj, At, Bt) do { __builtin_amdgcn_s_setprio(1); _Pragma("unroll") for (int m = 0; m < 4; ++m) _Pragma("unroll") for (int n = 0; n < 2; ++n) _Pragma("unroll") for (int k = 0; k < 2; ++k) \
        acc[ai][bj][m][n] = __builtin_amdgcn_mfma_f32_16x16x32_bf16(Bt[n][k], At[m][k], acc[ai][bj][m][n], 0, 0, 0); __builtin_amdgcn_s_setprio(0); } while (0)
#define PG8_WAIT_V(n) asm volatile("s_waitcnt vmcnt(" #n ")" ::: "memory")
#define PG8_WAIT_L(n) asm volatile("s_waitcnt lgkmcnt(" #n ")" ::: "memory")
#define PG8_BAR __builtin_amdgcn_s_barrier()
#define PG8_SCHED __builtin_amdgcn_sched_barrier(0)
    Unit cur, nxt; int ui = 0;
    if (!S.next(0, cur)) return;
    f32x4 acc[2][2][4][2];
#pragma unroll
    for (int a = 0; a < 2; ++a)
#pragma unroll
        for (int b = 0; b < 2; ++b)
#pragma unroll
            for (int m = 0; m < 4; ++m)
#pragma unroll
                for (int n = 0; n < 2; ++n) acc[a][b][m][n] = (f32x4){0.f, 0.f, 0.f, 0.f};
    bf16x8 At[4][2], B0[2][2], B1[2][2];
    {
        const char* cA = a_tile(g, cur.pm, 0); const char* cB = b_tile(g, cur.pn, 0); const char* cA1 = a_tile(g, cur.pm, 1); const char* cB1 = b_tile(g, cur.pn, 1);
        PG8_STAGE(PG8_SB(0, 0), cB, voffB); PG8_STAGE(PG8_SB(0, 1), cB + hstepB, voffB); PG8_STAGE(PG8_SA(0, 0), cA, voffA); PG8_STAGE(PG8_SA(0, 1), cA + hstepA, voffA);
        if (wr == 1) PG8_BAR;
        PG8_WAIT_V(2); PG8_BAR;
        PG8_STAGE(PG8_SB(1, 0), cB1, voffB); PG8_STAGE(PG8_SA(1, 0), cA1, voffA); PG8_STAGE(PG8_SB(1, 1), cB1 + hstepB, voffB);
        PG8_WAIT_V(6); PG8_BAR;
    }
    for (;;) {
        const bool has_next = S.next(ui + 1, nxt);
        const Unit nu = has_next ? nxt : cur;
        for (int t = 0; t < nt; t += 2) {
            const bool last = (t == nt - 2);
            if constexpr (Epi::HAS_MID) { if (t == g.ks) E.mid(acc, cur, wr, wc, fr, fq); }
            const char* a1 = a_tile(g, cur.pm, t + 1);
            const char* a2 = last ? a_tile(g, nu.pm, 0) : a_tile(g, cur.pm, t + 2); const char* b2 = last ? b_tile(g, nu.pn, 0) : b_tile(g, cur.pn, t + 2);
            const char* a3 = last ? a_tile(g, nu.pm, 1) : a_tile(g, cur.pm, t + 3); const char* b3 = last ? b_tile(g, nu.pn, 1) : b_tile(g, cur.pn, t + 3);
            PG8_LDB(B0, 0, 0); PG8_LDB(B1, 0, 1); PG8_SCHED; PG8_LDA(At, 0, 0); PG8_STAGE(PG8_SA(1, 1), a1 + hstepA, voffA);
            PG8_WAIT_V(8); PG8_WAIT_L(0); PG8_BAR; PG8_MMA(0, 0, At, B0); PG8_MMA(0, 1, At, B1); PG8_BAR; PG8_SCHED;
            PG8_LDA(At, 0, 1); PG8_STAGE(PG8_SB(0, 0), b2, voffB); PG8_STAGE(PG8_SB(0, 1), b2 + hstepB, voffB); PG8_STAGE(PG8_SA(0, 0), a2, voffA);
            PG8_WAIT_V(8); PG8_WAIT_L(0); PG8_BAR; PG8_MMA(1, 0, At, B0); PG8_MMA(1, 1, At, B1); PG8_BAR; PG8_SCHED;
            PG8_LDB(B0, 1, 0); PG8_LDB(B1, 1, 1); PG8_SCHED; PG8_LDA(At, 1, 0); PG8_STAGE(PG8_SA(0, 1), a2 + hstepA, voffA);
            PG8_WAIT_V(8); PG8_WAIT_L(0); PG8_BAR; PG8_MMA(0, 0, At, B0); PG8_MMA(0, 1, At, B1); PG8_BAR; PG8_SCHED;
            PG8_LDA(At, 1, 1); PG8_STAGE(PG8_SB(1, 0), b3, voffB); PG8_STAGE(PG8_SB(1, 1), b3 + hstepB, voffB); PG8_STAGE(PG8_SA(1, 0), a3, voffA);
            PG8_WAIT_V(8); PG8_WAIT_L(0); PG8_BAR; PG8_MMA(1, 0, At, B0); PG8_MMA(1, 1, At, B1); PG8_BAR; PG8_SCHED;
        }
        if constexpr (ALIGN_EPI) { if (wr == 0) PG8_BAR; }
        E(acc, cur, wr, wc, fr, fq, epi_lds);
        if (!has_next) break;
#pragma unroll
        for (int a = 0; a < 2; ++a)
#pragma unroll
            for (int b = 0; b < 2; ++b)
#pragma unroll
                for (int m = 0; m < 4; ++m)
#pragma unroll
                    for (int n = 0; n < 2; ++n) acc[a][b][m][n] = (f32x4){0.f, 0.f, 0.f, 0.f};
        cur = nxt; ++ui;
        if constexpr (ALIGN_EPI) { if (wr == 1) PG8_BAR; }
    }
    PG8_WAIT_V(0);
    if constexpr (!ALIGN_EPI) { if (wr == 0) PG8_BAR; }
    PG8_BAR;
#undef PG8_SA
#undef PG8_SB
#undef PG8_STAGE
#undef PG8_LDA
#undef PG8_LDB
#undef PG8_MMA
#undef PG8_WAIT_V
#undef PG8_WAIT_L
#undef PG8_BAR
#undef PG8_SCHED
}
}
using pg8::Unit;

struct EpiG1 {
    static constexpr bool PERM = true, HAS_MID = false;
    bf16_t *UG, *Z, *XL, *GL, *QR, *GB; const float* sgn; const float* bmerge; float* out;
    __device__ __forceinline__ void mid(f32x4 (&)[2][2][4][2], const Unit&, int, int, int, int) const {}
    __device__ __forceinline__ void operator()(f32x4 (&acc)[2][2][4][2], const Unit& u, int wr, int wc, int fr, int fq, LAS unsigned char* el) const {
        const int row0 = u.pm * 256 + wr * 64 + fr, cw = wc * 32 + 8 * fq, pn = u.pn;
        if (pn < 8) {
#pragma unroll
            for (int ai = 0; ai < 2; ++ai)
#pragma unroll
                for (int m = 0; m < 4; ++m) { const int row = row0 + ai * 128 + m * 16; float v[8];
#pragma unroll
                    for (int n = 0; n < 2; ++n)
#pragma unroll
                        for (int j = 0; j < 4; ++j) { const float uu = acc[ai][0][m][n][j], gg = acc[ai][1][m][n][j]; v[4 * n + j] = uu * gg * sigm(gg); }
                    u32x4 w; w.x = cvt_pk_bf16(v[0], v[1]); w.y = cvt_pk_bf16(v[2], v[3]); w.z = cvt_pk_bf16(v[4], v[5]); w.w = cvt_pk_bf16(v[6], v[7]);
                    *(u32x4*)(UG + (size_t)row * D + pn * 128 + cw) = w; }
        } else if (pn < 12) {
            const int h = pn - 8; LAS float* P = (LAS float*)el;
#pragma unroll
            for (int ai = 0; ai < 2; ++ai)
#pragma unroll
                for (int m = 0; m < 4; ++m) { float s = 0.f;
#pragma unroll
                    for (int bj = 0; bj < 2; ++bj)
#pragma unroll
                        for (int n = 0; n < 2; ++n) { const f32x4 x = acc[ai][bj][m][n]; s += (x[0] * x[0] + x[1] * x[1]) + (x[2] * x[2] + x[3] * x[3]); }
                    s += __shfl_xor(s, 16); s += __shfl_xor(s, 32);
                    if (fq == 0) P[(ai * 128 + wr * 64 + m * 16 + fr) * 4 + wc] = s; }
            asm volatile("s_waitcnt lgkmcnt(0)" ::: "memory"); __builtin_amdgcn_s_barrier(); asm volatile("" ::: "memory");
            f32x4 gn[2][2];
#pragma unroll
            for (int bj = 0; bj < 2; ++bj)
#pragma unroll
                for (int n = 0; n < 2; ++n) gn[bj][n] = *(const f32x4*)(sgn + h * 256 + bj * 128 + cw + 4 * n);
#pragma unroll
            for (int ai = 0; ai < 2; ++ai)
#pragma unroll
                for (int m = 0; m < 4; ++m) { const int lr = ai * 128 + wr * 64 + m * 16 + fr, row = u.pm * 256 + lr;
                    const f32x4 p4 = *(const LAS f32x4*)(P + lr * 4); const float rstd = __builtin_amdgcn_rsqf(((p4[0] + p4[1]) + (p4[2] + p4[3])) * (1.f / 256.f) + EPS);
#pragma unroll
                    for (int bj = 0; bj < 2; ++bj) { const f32x4 z0 = acc[ai][bj][m][0] * rstd * gn[bj][0], z1 = acc[ai][bj][m][1] * rstd * gn[bj][1];
                        u32x4 w; w.x = cvt_pk_bf16(z0[0], z0[1]); w.y = cvt_pk_bf16(z0[2], z0[3]); w.z = cvt_pk_bf16(z1[0], z1[1]); w.w = cvt_pk_bf16(z1[2], z1[3]);
                        const int col = h * 256 + bj * 128 + cw;
                        *(u32x4*)(Z + (size_t)row * D + col) = w;
                        if (row >= MP) { float* o = out + O_CHV + (size_t)(row - MP) * D + col; *(f32x4*)o = z0; *(f32x4*)(o + 4) = z1; } } }
            asm volatile("s_waitcnt lgkmcnt(0)" ::: "memory"); __builtin_amdgcn_s_barrier(); asm volatile("" ::: "memory");
        } else if (pn < 16) {
#pragma unroll
            for (int ai = 0; ai < 2; ++ai)
#pragma unroll
                for (int m = 0; m < 4; ++m) { const int row = row0 + ai * 128 + m * 16;
                    float* cdst = nullptr;
                    if (row < MP) { const int t = row & (SEQ - 1); if (t >= SEQ - 3) cdst = out + O_CONVP + (size_t)((row >> 11) * 3 + (t - (SEQ - 3))) * D; }
                    else { const int rs = row - MP, t = rs & 3; if (t >= 1) cdst = out + O_CONVS + (size_t)((rs >> 2) * 3 + (t - 1)) * D; }
#pragma unroll
                    for (int bj = 0; bj < 2; ++bj) { const f32x4 z0 = acc[ai][bj][m][0], z1 = acc[ai][bj][m][1];
                        u32x4 w; w.x = cvt_pk_bf16(z0[0], z0[1]); w.y = cvt_pk_bf16(z0[2], z0[3]); w.z = cvt_pk_bf16(z1[0], z1[1]); w.w = cvt_pk_bf16(z1[2], z1[3]);
                        const int col = (pn - 12) * 256 + bj * 128 + cw;
                        *(u32x4*)(XL + (size_t)row * D + col) = w;
                        if (cdst) { *(f32x4*)(cdst + col) = z0; *(f32x4*)(cdst + col + 4) = z1; } } }
        } else if (pn < 20) {
#pragma unroll
            for (int ai = 0; ai < 2; ++ai)
#pragma unroll
                for (int m = 0; m < 4; ++m) { const int row = row0 + ai * 128 + m * 16;
#pragma unroll
                    for (int bj = 0; bj < 2; ++bj) { float v[8];
#pragma unroll
                        for (int n = 0; n < 2; ++n)
#pragma unroll
                            for (int j = 0; j < 4; ++j) { const float gg = acc[ai][bj][m][n][j]; v[4 * n + j] = gg * sigm(gg); }
                        u32x4 w; w.x = cvt_pk_bf16(v[0], v[1]); w.y = cvt_pk_bf16(v[2], v[3]); w.z = cvt_pk_bf16(v[4], v[5]); w.w = cvt_pk_bf16(v[6], v[7]);
                        *(u32x4*)(GL + (size_t)row * D + (pn - 16) * 256 + bj * 128 + cw) = w; } }
        } else {
            const int c0 = (pn - 20) * 128 + cw;
            f32x4 ba[2], bb[2];
#pragma unroll
            for (int n = 0; n < 2; ++n) { ba[n] = *(const f32x4*)(bmerge + c0 + 4 * n); bb[n] = *(const f32x4*)(bmerge + D + c0 + 4 * n); }
#pragma unroll
            for (int ai = 0; ai < 2; ++ai)
#pragma unroll
                for (int m = 0; m < 4; ++m) { const int row = row0 + ai * 128 + m * 16; float q[8], gbv[8];
#pragma unroll
                    for (int n = 0; n < 2; ++n)
#pragma unroll
                        for (int j = 0; j < 4; ++j) { const float a = acc[ai][0][m][n][j] + ba[n][j], b = acc[ai][1][m][n][j] + bb[n][j];
                            const float eb = __builtin_amdgcn_exp2f(-1.44269504089f * b); const float ga = sigm(a);
                            gbv[4 * n + j] = fmaxf(__builtin_amdgcn_rcpf(1.f + eb), 1e-30f); q[4 * n + j] = fminf(ga * (1.f + eb), 3.0e38f); }
                    u32x4 w; w.x = cvt_pk_bf16(q[0], q[1]); w.y = cvt_pk_bf16(q[2], q[3]); w.z = cvt_pk_bf16(q[4], q[5]); w.w = cvt_pk_bf16(q[6], q[7]);
                    *(u32x4*)(QR + (size_t)row * D + c0) = w;
                    w.x = cvt_pk_bf16(gbv[0], gbv[1]); w.y = cvt_pk_bf16(gbv[2], gbv[3]); w.z = cvt_pk_bf16(gbv[4], gbv[5]); w.w = cvt_pk_bf16(gbv[6], gbv[7]);
                    *(u32x4*)(GB + (size_t)row * D + c0) = w; }
        }
    }
};
struct EpiG2 {
    static constexpr bool PERM = true, HAS_MID = true;
    const bf16_t *QR, *GB; bf16_t* MRG;
    __device__ __forceinline__ void mid(f32x4 (&acc)[2][2][4][2], const Unit& u, int wr, int wc, int fr, int fq) const {
        unsigned off0 = (unsigned)((u.pm * 256 + wr * 64 + fr) * D + u.pn * 256 + wc * 32 + 8 * fq) * 2u; asm volatile("" : "+v"(off0));
#pragma unroll
        for (int ai = 0; ai < 2; ++ai)
#pragma unroll
            for (int m = 0; m < 4; ++m) {
#pragma unroll
                for (int bj = 0; bj < 2; ++bj) { const u32x4 q = *(const u32x4*)((const char*)QR + (off0 + (unsigned)(((ai * 128 + m * 16) * D + bj * 128) * 2)));
                    acc[ai][bj][m][0] *= (f32x4){bf_lo(q.x), bf_hi(q.x), bf_lo(q.y), bf_hi(q.y)}; acc[ai][bj][m][1] *= (f32x4){bf_lo(q.z), bf_hi(q.z), bf_lo(q.w), bf_hi(q.w)}; }
                if (m & 1) asm volatile("" ::: "memory"); }
    }
    __device__ __forceinline__ void operator()(f32x4 (&acc)[2][2][4][2], const Unit& u, int wr, int wc, int fr, int fq, LAS unsigned char*) const {
        unsigned off0 = (unsigned)((u.pm * 256 + wr * 64 + fr) * D + u.pn * 256 + wc * 32 + 8 * fq) * 2u; asm volatile("" : "+v"(off0));
#pragma unroll
        for (int ai = 0; ai < 2; ++ai)
#pragma unroll
            for (int m = 0; m < 4; ++m) {
#pragma unroll
                for (int bj = 0; bj < 2; ++bj) { const unsigned off = off0 + (unsigned)(((ai * 128 + m * 16) * D + bj * 128) * 2); const u32x4 q = *(const u32x4*)((const char*)GB + off);
                    const f32x4 v0 = acc[ai][bj][m][0] * (f32x4){bf_lo(q.x), bf_hi(q.x), bf_lo(q.y), bf_hi(q.y)}, v1 = acc[ai][bj][m][1] * (f32x4){bf_lo(q.z), bf_hi(q.z), bf_lo(q.w), bf_hi(q.w)};
                    u32x4 w; w.x = cvt_pk_bf16(v0[0], v0[1]); w.y = cvt_pk_bf16(v0[2], v0[3]); w.z = cvt_pk_bf16(v1[0], v1[1]); w.w = cvt_pk_bf16(v1[2], v1[3]);
                    *(u32x4*)((char*)MRG + off) = w; }
                if (m & 1) asm volatile("" ::: "memory"); }
    }
};
struct EpiF32 {
    static constexpr bool PERM = false, HAS_MID = false;
    float* dst;
    __device__ __forceinline__ void mid(f32x4 (&)[2][2][4][2], const Unit&, int, int, int, int) const {}
    __device__ __forceinline__ void operator()(f32x4 (&acc)[2][2][4][2], const Unit& u, int wr, int wc, int fr, int fq, LAS unsigned char*) const {
        const int row0 = u.pm * 256 + wr * 64 + fr, c0 = u.pn * 256 + wc * 32 + 4 * fq;
#pragma unroll
        for (int ai = 0; ai < 2; ++ai)
#pragma unroll
            for (int m = 0; m < 4; ++m)
#pragma unroll
                for (int bj = 0; bj < 2; ++bj)
#pragma unroll
                    for (int n = 0; n < 2; ++n) *(f32x4*)(dst + (size_t)(row0 + ai * 128 + m * 16) * D + c0 + bj * 128 + n * 16) = acc[ai][bj][m][n];
    }
};
struct EpiFinal {
    static constexpr bool PERM = false, HAS_MID = false;
    const float* X1F; const float* bias; float* out;
    __device__ __forceinline__ void mid(f32x4 (&)[2][2][4][2], const Unit&, int, int, int, int) const {}
    __device__ __forceinline__ void operator()(f32x4 (&acc)[2][2][4][2], const Unit& u, int wr, int wc, int fr, int fq, LAS unsigned char*) const {
        const int row0 = u.pm * 256 + wr * 64 + fr, c0 = u.pn * 256 + wc * 32 + 4 * fq;
#pragma unroll
        for (int bj = 0; bj < 2; ++bj)
#pragma unroll
            for (int n = 0; n < 2; ++n) { const f32x4 bv = *(const f32x4*)(bias + c0 + bj * 128 + n * 16);
#pragma unroll
                for (int ai = 0; ai < 2; ++ai)
#pragma unroll
                    for (int m = 0; m < 4; ++m) { const size_t off = (size_t)(row0 + ai * 128 + m * 16) * D + c0 + bj * 128 + n * 16;
                        const f32x4 x1 = *(const f32x4*)(X1F + off), e = *(const f32x4*)(out + off), a = acc[ai][bj][m][n] + bv;
                        f32x4 o; o[0] = x1[0] + sigm(a[0]) * e[0]; o[1] = x1[1] + sigm(a[1]) * e[1]; o[2] = x1[2] + sigm(a[2]) * e[2]; o[3] = x1[3] + sigm(a[3]) * e[3];
                        *(f32x4*)(out + off) = o; } }
    }
};

#define XB_TMO      128
#define XB_XCNT(j)  (256  + 64 * (j))
#define XB_XSUB(j)  (1280 + 64 * (j))
#define XB_XGEN(j)  (2304 + 64 * (j))
#define XB_TOP      3328
#define XB_TOPGEN   3392
#define XCD_BAR_WORDS 3456
#define XB_SPIN_CAP (1u << 18)
__device__ __forceinline__ unsigned xb_ld(unsigned* p)              { return __hip_atomic_load(p, __ATOMIC_RELAXED, __HIP_MEMORY_SCOPE_AGENT); }
__device__ __forceinline__ unsigned xb_add(unsigned* p, unsigned v) { return __hip_atomic_fetch_add(p, v, __ATOMIC_RELAXED, __HIP_MEMORY_SCOPE_AGENT); }
__device__ __forceinline__ unsigned xb_xcc_id() { return (unsigned)__builtin_amdgcn_s_getreg((3 << 11) | 20) & 0xFu; }
#define XB_SPIN(cond, bar) do { unsigned _sp = 0; while (cond) { __builtin_amdgcn_s_sleep(1); \
    if ((++_sp & 255u) == 0u) { if (xb_ld(&(bar)[XB_TMO])) break; if (_sp > XB_SPIN_CAP) { atomicAdd(&(bar)[XB_TMO], 1u); break; } } } } while (0)
struct XcdBarrier { unsigned* bar; unsigned x; volatile LAS unsigned* st; };
__device__ __forceinline__ XcdBarrier xcd_barrier_post(unsigned* bar, volatile LAS unsigned* st) {
    XcdBarrier b; b.bar = bar; b.x = xb_xcc_id(); b.st = st;
    if (threadIdx.x == 0) (void)xb_add(&bar[XB_XCNT(b.x)], 1u);
    return b;
}
__device__ __forceinline__ void xcd_barrier_complete(unsigned* bar, unsigned x, unsigned& nloc, unsigned& nx) {
    const unsigned G = gridDim.x * gridDim.y * gridDim.z;
    unsigned sum, cnt, mine, sp = 0u;
    for (;;) {
        sum = 0u; cnt = 0u; mine = 0u;
#pragma unroll
        for (unsigned j = 0; j < 16; ++j) { const unsigned c = xb_ld(&bar[XB_XCNT(j)]); sum += c; cnt += (c > 0u) ? 1u : 0u; mine = (j == x) ? c : mine; }
        if (sum == G) break;
        __builtin_amdgcn_s_sleep(1);
        if ((++sp & 255u) == 0u) { if (xb_ld(&bar[XB_TMO])) break; if (sp > XB_SPIN_CAP) { atomicAdd(&bar[XB_TMO], 1u); break; } }
    }
    nloc = mine > 0u ? mine : 1u; nx = cnt > 0u ? cnt : 1u;
}
__device__ __forceinline__ void xcd_barrier(const XcdBarrier& b) {
    asm volatile("s_waitcnt vmcnt(0)" ::: "memory");
    __syncthreads();
    if (threadIdx.x == 0) {
        unsigned* bar = b.bar;
        __builtin_amdgcn_s_waitcnt(0);
        unsigned nloc = b.st[0], nx = b.st[1];
        if (nloc == 0u) { xcd_barrier_complete(bar, b.x, nloc, nx); b.st[0] = nloc; b.st[1] = nx; }
        const unsigned old = xb_add(&bar[XB_XSUB(b.x)], 1u);
        const unsigned gen = old / nloc;
        if (old + 1u == (gen + 1u) * nloc) {
            __builtin_amdgcn_fence(__ATOMIC_RELEASE, "agent");
            asm volatile("s_waitcnt vmcnt(0)" ::: "memory");
            const unsigned og = xb_add(&bar[XB_TOP], 1u);
            const unsigned tg = og / nx;
            if (og + 1u == (tg + 1u) * nx) xb_add(&bar[XB_TOPGEN], 1u);
            else XB_SPIN(xb_ld(&bar[XB_TOPGEN]) == tg, bar);
            __builtin_amdgcn_fence(__ATOMIC_ACQUIRE, "agent");
            xb_add(&bar[XB_XGEN(b.x)], 1u);
            asm volatile("s_waitcnt vmcnt(0)" ::: "memory");
        } else {
            XB_SPIN(xb_ld(&bar[XB_XGEN(b.x)]) == gen, bar);
            __builtin_amdgcn_fence(__ATOMIC_ACQUIRE, "agent");
            asm volatile("s_waitcnt vmcnt(0)" ::: "memory");
        }
    }
    __syncthreads();
}

__device__ __forceinline__ void p0_transpose_item(const float* W, int Nsrc, int scol0, int k0, bf16_t* WT, int ldd, int drow0, int dk0, LAS float* scr, int lane) {
#pragma unroll 8
    for (int i = 0; i < 32; ++i) { const int kk = 2 * i + (lane >> 5); scr[kk * 33 + (lane & 31)] = W[(size_t)(k0 + kk) * Nsrc + scol0 + (lane & 31)]; }
    LDS_WAIT(); asm volatile("" ::: "memory");
    const int c = lane & 7;
#pragma unroll
    for (int j = 0; j < 4; ++j) { const int n = (lane >> 3) + 8 * j; const LAS float* s = scr + (8 * c) * 33 + n;
        u32x4 o; o.x = cvt_pk_bf16(s[0 * 33], s[1 * 33]); o.y = cvt_pk_bf16(s[2 * 33], s[3 * 33]); o.z = cvt_pk_bf16(s[4 * 33], s[5 * 33]); o.w = cvt_pk_bf16(s[6 * 33], s[7 * 33]);
        *(u32x4*)(WT + (size_t)(drow0 + n) * ldd + dk0 + 8 * c) = o; }
    LDS_WAIT(); asm volatile("" ::: "memory");
}

struct Args { const float* in[27]; float* out; unsigned char* ws; int pad0, pad1; };

__global__ void __launch_bounds__(NWAVES * 64, 2) mixer_fwd(Args args) {
    extern __shared__ __attribute__((aligned(16))) unsigned char lds_raw[];
    LAS unsigned char* lds = (LAS unsigned char*)lds_raw;
    volatile LAS unsigned* MISC = (volatile LAS unsigned*)(lds + MISC_OFF);
    const int tid = threadIdx.x, lane = tid & 63, wave = __builtin_amdgcn_readfirstlane(tid >> 6);
    const int G = gridDim.x; const int bx = blockIdx.x; const int vcu = (G % 8 == 0) ? (bx % 8) * (G / 8) + bx / 8 : bx;
    typedef const Args __attribute__((address_space(4))) CArgs;
    CArgs* const args_c = (CArgs*)__builtin_amdgcn_kernarg_segment_ptr();
#define KARGS() ({ CArgs* _p = args_c; asm volatile("" : "+s"(_p)); _p; })
    unsigned char* ws; float* out; { CArgs* A = KARGS(); ws = A->ws; out = A->out; }
    bf16_t* WIN = (bf16_t*)(ws + WS_WIN); bf16_t* WBR = (bf16_t*)(ws + WS_WBR); bf16_t* WOUT = (bf16_t*)(ws + WS_WOUT); bf16_t* WPG = (bf16_t*)(ws + WS_WPG); bf16_t* WPLE = (bf16_t*)(ws + WS_WPLE);
    bf16_t* LWA = (bf16_t*)(ws + WS_LWA); bf16_t* LWX = (bf16_t*)(ws + WS_LWX); bf16_t* SGW = (bf16_t*)(ws + WS_SGW); bf16_t* PB = (bf16_t*)(ws + WS_PB);
    bf16_t* H = (bf16_t*)out;
    bf16_t* UG = (bf16_t*)(ws + WS_R0); bf16_t* Z = (bf16_t*)(ws + WS_R1); bf16_t* XL = (bf16_t*)(ws + WS_R2); bf16_t* GL = (bf16_t*)(ws + WS_R3); bf16_t* QR = (bf16_t*)(ws + WS_R4); bf16_t* GB = (bf16_t*)(ws + WS_R5);
    bf16_t* MRG = (bf16_t*)(ws + WS_R1);
    float* X1F = (float*)(ws + WS_R4);
    bf16_t* X1B = (bf16_t*)(ws + WS_R0);

    for (int u = tid; u < (LDS_BYTES - MISC_OFF) / 4; u += NWAVES * 64) ((LAS unsigned*)(lds + MISC_OFF))[u] = 0u;
    __syncthreads();
    XcdBarrier bar = xcd_barrier_post((unsigned*)(ws + WS_CTL) + CW_BAR, MISC + 8);

    {
        CArgs* KA = KARGS();
        const float* x_prompt = KA->in[0]; const float* x_sample = KA->in[1]; const float* p_prompt = KA->in[2]; const float* p_sample = KA->in[3]; const float* norm_pre = KA->in[6]; const float* w_in = KA->in[7];
        const float* sg_w = KA->in[9]; const float* lru_wa = KA->in[13]; const float* lru_wx = KA->in[15]; const float* w_br_sg = KA->in[18]; const float* w_br_lru = KA->in[19]; const float* w_merge = KA->in[20];
        const float* w_out = KA->in[22]; const float* w_ple = KA->in[24]; const float* w_pg = KA->in[25];
        LAS float* scr = (LAS float*)(lds + wave * 16384);
        const int gw = vcu * NWAVES + wave, NGW = G * NWAVES;
        constexpr int I_WIN = (NIN / 32) * 16, I_WBR = 32 * 32, I_WOUT = 32 * 16, I_WPG = 32 * 16, I_WPLE = 32 * 4, I_LRU = 2 * 8 * 4 * 2;
        constexpr int NITEMS = I_WIN + I_WBR + I_WOUT + I_WPG + I_WPLE + I_LRU;
        for (int it = gw; it < NITEMS; it += NGW) {
            int r = it;
            if (r < I_WIN) { const int rb = r >> 4, kb = r & 15, pn = rb >> 3, q = rb & 7; const float* src; int ns, sc;
                if (pn < 8)       { src = w_in; ns = 5120; sc = (q < 4) ? (pn * 128 + q * 32) : (2048 + pn * 128 + (q - 4) * 32); }
                else if (pn < 12) { src = w_in; ns = 5120; sc = 1024 + (pn - 8) * 256 + q * 32; }
                else if (pn < 16) { src = w_in; ns = 5120; sc = 3072 + (pn - 12) * 256 + q * 32; }
                else if (pn < 20) { src = w_in; ns = 5120; sc = 4096 + (pn - 16) * 256 + q * 32; }
                else              { src = w_merge; ns = 2048; sc = (q < 4) ? ((pn - 20) * 128 + q * 32) : (1024 + (pn - 20) * 128 + (q - 4) * 32); }
                p0_transpose_item(src, ns, sc, kb * 64, WIN, 1024, rb * 32, kb * 64, scr, lane); continue; }
            r -= I_WIN;
            if (r < I_WBR) { const int rb = r >> 5, kb = r & 31; const float* src = kb < 16 ? w_br_sg : w_br_lru;
                p0_transpose_item(src, 1024, rb * 32, (kb & 15) * 64, WBR, 2048, rb * 32, kb * 64, scr, lane); continue; }
            r -= I_WBR;
            if (r < I_WOUT) { const int rb = r >> 4, kb = r & 15; p0_transpose_item(w_out, 1024, rb * 32, kb * 64, WOUT, 1024, rb * 32, kb * 64, scr, lane); continue; }
            r -= I_WOUT;
            if (r < I_WPG) { const int rb = r >> 4, kb = r & 15; p0_transpose_item(w_pg, 1024, rb * 32, kb * 64, WPG, 1024, rb * 32, kb * 64, scr, lane); continue; }
            r -= I_WPG;
            if (r < I_WPLE) { const int rb = r >> 2, kb = r & 3; p0_transpose_item(w_ple, 1024, rb * 32, kb * 64, WPLE, 256, rb * 32, kb * 64, scr, lane); continue; }
            r -= I_WPLE;
            { const int g = r >> 6, n = (r >> 3) & 7, rb = (r >> 1) & 3, kb = r & 1;
              p0_transpose_item((g ? lru_wx : lru_wa) + (size_t)n * 128 * 128, 128, rb * 32, kb * 64, (g ? LWX : LWA) + (size_t)n * 128 * 128, 128, rb * 32, kb * 64, scr, lane); }
        }
        for (int i = vcu * 512 + tid; i < 4 * 128 * 128; i += G * 512) { const int t = (i >> 7) & 127, s = i & 127; const float v = (s <= t) ? sg_w[i] : 0.f; SGW[i] = (bf16_t)(cvt_pk_bf16(v, 0.f) & 0xffffu); }
        for (int m = gw; m < M; m += NGW) {
            const float* xrow = (m < MP) ? x_prompt + (size_t)m * D : x_sample + (size_t)(m - MP) * D;
            const f32x4* xr = (const f32x4*)xrow + lane; f32x4 v[4]; float s = 0.f;
#pragma unroll
            for (int j = 0; j < 4; ++j) { v[j] = xr[64 * j]; s += (v[j][0] * v[j][0] + v[j][1] * v[j][1]) + (v[j][2] * v[j][2] + v[j][3] * v[j][3]); }
            const float rstd = 1.f / sqrtf(wave_sum(s) * (1.f / D) + EPS);
            u32x2* o8 = (u32x2*)(H + (size_t)m * D) + lane;
#pragma unroll
            for (int j = 0; j < 4; ++j) { const f32x4 gn = *((const f32x4*)norm_pre + lane + 64 * j); const f32x4 y = v[j] * rstd * gn;
                u32x2 w; w.x = cvt_pk_bf16(y[0], y[1]); w.y = cvt_pk_bf16(y[2], y[3]); o8[64 * j] = w; }
        }
        for (int i = vcu * 512 + tid; i < M * PLE / 8; i += G * 512) { const int row = i >> 5, c8 = i & 31;
            const float* src = (row < MP ? p_prompt + (size_t)row * PLE : p_sample + (size_t)(row - MP) * PLE) + c8 * 8;
            const f32x4 a = *(const f32x4*)src, b = *(const f32x4*)(src + 4);
            u32x4 w; w.x = cvt_pk_bf16(a[0], a[1]); w.y = cvt_pk_bf16(a[2], a[3]); w.z = cvt_pk_bf16(b[0], b[1]); w.w = cvt_pk_bf16(b[2], b[3]);
            *(u32x4*)(PB + (size_t)row * PLE + c8 * 8) = w; }
    }
    xcd_barrier(bar);

    {
        CArgs* KA = KARGS(); const float* sg_norm = KA->in[8]; const float* b_merge = KA->in[21];
        pg8::Gemm g{H, H, WIN, 1024, 1024, 16, 16}; pg8::StaticOrder S; S.init(M, NIN, G, bx);
        EpiG1 E{UG, Z, XL, GL, QR, GB, sg_norm, b_merge, out};
        pg8::gemm_phase<EpiG1, true>(lds, lds + EPI_OFF, g, S, E);
    }
    xcd_barrier(bar);

    {
        CArgs* KA = KARGS();
        const float* state_conv = KA->in[4]; const float* state_lru = KA->in[5]; const float* sg_w = KA->in[9]; const float* sg_b = KA->in[10]; const float* conv_w = KA->in[11]; const float* conv_b = KA->in[12];
        const float* lru_wa = KA->in[13]; const float* lru_ba = KA->in[14]; const float* lru_wx = KA->in[15]; const float* lru_bx = KA->in[16]; const float* lru_lambda = KA->in[17];
        const int fr = lane & 15, fq = lane >> 4;
        for (int item = 2 * vcu; item < 2 * vcu + 2 && item < 512; ++item) {
            const int c = item >> 2, h = item & 3, r0 = c * 128;
            LAS unsigned char* Zs = lds; LAS unsigned char* Ws = lds + 69632;
#pragma unroll
            for (int j = 0; j < 8; ++j) { const int idx = tid + 512 * j, row = idx >> 5, c16 = idx & 31;
                *(LAS u32x4*)(Zs + row * 544 + 16 * c16) = *(const u32x4*)(Z + (size_t)(r0 + row) * D + 256 * h + 8 * c16); }
#pragma unroll
            for (int j = 0; j < 4; ++j) { const int idx = tid + 512 * j, row = idx >> 4, c16 = idx & 15;
                *(LAS u32x4*)(Ws + row * 272 + 16 * c16) = *(const u32x4*)(SGW + (size_t)(h * 128 + row) * 128 + 8 * c16); }
            __syncthreads();
            f32x4 acc[2][8];
#pragma unroll
            for (int a = 0; a < 2; ++a)
#pragma unroll
                for (int b = 0; b < 8; ++b) acc[a][b] = (f32x4){0.f, 0.f, 0.f, 0.f};
#pragma unroll
            for (int ks = 0; ks < 4; ++ks) { const int k0 = 32 * ks; bf16x8 zf[2];
#pragma unroll
                for (int dbi = 0; dbi < 2; ++dbi) { const int d0 = 16 * (2 * wave + dbi);
                    LAS unsigned char* a0 = Zs + (k0 + 8 * fq + (fr >> 2)) * 544 + (d0 + 4 * (fr & 3)) * 2;
                    const s16x4 lo = __builtin_bit_cast(s16x4, __builtin_amdgcn_ds_read_tr16_b64_v4i16((LAS s16x4*)a0));
                    const s16x4 hi = __builtin_bit_cast(s16x4, __builtin_amdgcn_ds_read_tr16_b64_v4i16((LAS s16x4*)(a0 + 4 * 544)));
                    zf[dbi] = (bf16x8){lo[0], lo[1], lo[2], lo[3], hi[0], hi[1], hi[2], hi[3]}; }
#pragma unroll
                for (int tb = 0; tb < 8; ++tb) if (tb >= 2 * ks) { const bf16x8 wf = *(const LAS bf16x8*)(Ws + (16 * tb + fr) * 272 + (k0 + 8 * fq) * 2);
                    acc[0][tb] = __builtin_amdgcn_mfma_f32_16x16x32_bf16(zf[0], wf, acc[0][tb], 0, 0, 0); acc[1][tb] = __builtin_amdgcn_mfma_f32_16x16x32_bf16(zf[1], wf, acc[1][tb], 0, 0, 0); } }
#pragma unroll
            for (int tb = 0; tb < 8; ++tb) { const int t = 16 * tb + fr; const float bias = sg_b[h * 128 + t];
#pragma unroll
                for (int dbi = 0; dbi < 2; ++dbi) { bf16_t* pp = UG + (size_t)(r0 + t) * D + 256 * h + 16 * (2 * wave + dbi) + 4 * fq; const u32x2 ug = *(const u32x2*)pp;
                    u32x2 w; w.x = cvt_pk_bf16(bf_lo(ug.x) * (acc[dbi][tb][0] + bias), bf_hi(ug.x) * (acc[dbi][tb][1] + bias)); w.y = cvt_pk_bf16(bf_lo(ug.y) * (acc[dbi][tb][2] + bias), bf_hi(ug.y) * (acc[dbi][tb][3] + bias));
                    *(u32x2*)pp = w; } }
            __syncthreads();
        }
        for (int idx = vcu * 512 + tid; idx < DBATCH * 128; idx += G * 512) { const int b = idx >> 7, col = (idx & 127) * 8, h = col >> 8;
            float zr[4][8];
#pragma unroll
            for (int s = 0; s < 4; ++s) { const u32x4 q = *(const u32x4*)(Z + (size_t)(MP + 4 * b + s) * D + col);
                zr[s][0] = bf_lo(q.x); zr[s][1] = bf_hi(q.x); zr[s][2] = bf_lo(q.y); zr[s][3] = bf_hi(q.y); zr[s][4] = bf_lo(q.z); zr[s][5] = bf_hi(q.z); zr[s][6] = bf_lo(q.w); zr[s][7] = bf_hi(q.w); }
#pragma unroll
            for (int t = 0; t < 4; ++t) { float sv[8]; const float bias = sg_b[h * 128 + t];
#pragma unroll
                for (int j = 0; j < 8; ++j) sv[j] = bias;
#pragma unroll
                for (int s = 0; s <= t; ++s) { const float w = sg_w[(size_t)(h * 128 + t) * 128 + s];
#pragma unroll
                    for (int j = 0; j < 8; ++j) sv[j] += w * zr[s][j]; }
                bf16_t* pp = UG + (size_t)(MP + 4 * b + t) * D + col; const u32x4 q = *(const u32x4*)pp;
                u32x4 w; w.x = cvt_pk_bf16(bf_lo(q.x) * sv[0], bf_hi(q.x) * sv[1]); w.y = cvt_pk_bf16(bf_lo(q.y) * sv[2], bf_hi(q.y) * sv[3]); w.z = cvt_pk_bf16(bf_lo(q.z) * sv[4], bf_hi(q.z) * sv[5]); w.w = cvt_pk_bf16(bf_lo(q.w) * sv[6], bf_hi(q.w) * sv[7]);
                *(u32x4*)pp = w; } }
        if (vcu < 256) {
            const int b = vcu >> 5, sl = vcu & 31, n = sl >> 2, sub = sl & 3, chb = 128 * n + 32 * sub;
            LAS unsigned char* Xs = lds; LAS unsigned char* XCs = lds + 35840; LAS f32x2* AB = (LAS f32x2*)(lds + 70656); LAS f32x2* SEG = (LAS f32x2*)(lds + 103424);
            LAS float* CARRY = (LAS float*)(lds + 107520); LAS float* CH = (LAS float*)(lds + 107776);
            bf16x8 wfr[2][2][4];
#pragma unroll
            for (int g = 0; g < 2; ++g)
#pragma unroll
                for (int cb = 0; cb < 2; ++cb)
#pragma unroll
                    for (int ks = 0; ks < 4; ++ks) wfr[g][cb][ks] = *(const bf16x8*)((g ? LWX : LWA) + (size_t)(n * 128 + 32 * sub + 16 * cb + fr) * 128 + 32 * ks + 8 * fq);
            if (tid < 32) { const int ch = chb + tid; CARRY[tid] = 0.f; const float xl = -lru_lambda[ch];
                const float sp = fmaxf(xl, 0.f) + log1pf(expf(-fabsf(xl)));
                CH[tid * 8 + 0] = lru_ba[ch]; CH[tid * 8 + 1] = lru_bx[ch]; CH[tid * 8 + 2] = -8.f * sp; CH[tid * 8 + 3] = conv_b[ch];
                CH[tid * 8 + 4] = conv_w[ch]; CH[tid * 8 + 5] = conv_w[D + ch]; CH[tid * 8 + 6] = conv_w[2 * D + ch]; CH[tid * 8 + 7] = conv_w[3 * D + ch]; }
            __syncthreads();
            for (int tc = 0; tc < 16; ++tc) {
                const int r0 = b * SEQ + 128 * tc;
                for (int idx = tid; idx < 131 * 16; idx += 512) { const int row = idx >> 4, c16 = idx & 15; u32x4 v = (u32x4){0u, 0u, 0u, 0u};
                    if (tc > 0 || row >= 3) v = *(const u32x4*)(XL + (size_t)(r0 - 3 + row) * D + 128 * n + 8 * c16);
                    *(LAS u32x4*)(Xs + row * 272 + 16 * c16) = v; }
                __syncthreads();
#pragma unroll
                for (int it = 0; it < 4; ++it) { const int idx = tid + 512 * it, t = idx >> 4, kg = idx & 15; const int c0 = 128 * n + 8 * kg;
                    float a8[8]; { const f32x4 c0v = *(const f32x4*)(conv_b + c0), c1v = *(const f32x4*)(conv_b + c0 + 4); a8[0] = c0v[0]; a8[1] = c0v[1]; a8[2] = c0v[2]; a8[3] = c0v[3]; a8[4] = c1v[0]; a8[5] = c1v[1]; a8[6] = c1v[2]; a8[7] = c1v[3]; }
#pragma unroll
                    for (int jj = 0; jj < 4; ++jj) { const u32x4 q = *(const LAS u32x4*)(Xs + (t + jj) * 272 + 16 * kg); const f32x4 w0 = *(const f32x4*)(conv_w + jj * D + c0), w1 = *(const f32x4*)(conv_w + jj * D + c0 + 4);
                        a8[0] += w0[0] * bf_lo(q.x); a8[1] += w0[1] * bf_hi(q.x); a8[2] += w0[2] * bf_lo(q.y); a8[3] += w0[3] * bf_hi(q.y);
                        a8[4] += w1[0] * bf_lo(q.z); a8[5] += w1[1] * bf_hi(q.z); a8[6] += w1[2] * bf_lo(q.w); a8[7] += w1[3] * bf_hi(q.w); }
                    u32x4 w; w.x = cvt_pk_bf16(a8[0], a8[1]); w.y = cvt_pk_bf16(a8[2], a8[3]); w.z = cvt_pk_bf16(a8[4], a8[5]); w.w = cvt_pk_bf16(a8[6], a8[7]);
                    *(LAS u32x4*)(XCs + t * 272 + 16 * kg) = w; }
                __syncthreads();
                f32x4 ga[2][2];
#pragma unroll
                for (int g = 0; g < 2; ++g)
#pragma unroll
                    for (int cb = 0; cb < 2; ++cb) ga[g][cb] = (f32x4){0.f, 0.f, 0.f, 0.f};
#pragma unroll
                for (int ks = 0; ks < 4; ++ks) { const bf16x8 xf = *(const LAS bf16x8*)(XCs + (16 * wave + fr) * 272 + (32 * ks + 8 * fq) * 2);
#pragma unroll
                    for (int g = 0; g < 2; ++g)
#pragma unroll
                        for (int cb = 0; cb < 2; ++cb) ga[g][cb] = __builtin_amdgcn_mfma_f32_16x16x32_bf16(wfr[g][cb][ks], xf, ga[g][cb], 0, 0, 0); }
                { const int t = 16 * wave + fr;
#pragma unroll
                  for (int cb = 0; cb < 2; ++cb)
#pragma unroll
                      for (int j = 0; j < 4; ++j) { const int chl = 16 * cb + 4 * fq + j; const f32x4 k0 = *(const LAS f32x4*)(CH + chl * 8), k1 = *(const LAS f32x4*)(CH + chl * 8 + 4);
                          const float r = sigm(ga[0][cb][j] + k0[0]), ig = sigm(ga[1][cb][j] + k0[1]), la = k0[2] * r, a = __expf(la), mult = sqrtf(-expm1f(2.f * la));
                          const int kc = 32 * sub + chl;
                          float xcv = k0[3];
                          xcv += k1[0] * bf2f(*(const LAS bf16_t*)(Xs + (t + 0) * 272 + 2 * kc)); xcv += k1[1] * bf2f(*(const LAS bf16_t*)(Xs + (t + 1) * 272 + 2 * kc));
                          xcv += k1[2] * bf2f(*(const LAS bf16_t*)(Xs + (t + 2) * 272 + 2 * kc)); xcv += k1[3] * bf2f(*(const LAS bf16_t*)(Xs + (t + 3) * 272 + 2 * kc));
                          AB[t * 32 + chl] = (f32x2){a, mult * ig * xcv}; } }
                __syncthreads();
                { const int ch = tid & 31, seg = tid >> 5; float A = 1.f, Hh = 0.f;
#pragma unroll
                  for (int i = 0; i < 8; ++i) { const f32x2 ab = AB[(8 * seg + i) * 32 + ch]; Hh = ab[0] * Hh + ab[1]; A *= ab[0]; }
                  SEG[seg * 32 + ch] = (f32x2){A, Hh};
                  __syncthreads();
                  float h = CARRY[ch];
                  for (int s = 0; s < seg; ++s) { const f32x2 sh = SEG[s * 32 + ch]; h = sh[0] * h + sh[1]; }
#pragma unroll
                  for (int i = 0; i < 8; ++i) { const f32x2 ab = AB[(8 * seg + i) * 32 + ch]; h = ab[0] * h + ab[1];
                      bf16_t* pp = GL + (size_t)(r0 + 8 * seg + i) * D + chb + ch; const float y = h * bf2f(*pp); *pp = (bf16_t)(cvt_pk_bf16(y, 0.f) & 0xffffu); }
                  __syncthreads();
                  if (seg == 15) CARRY[ch] = h; }
            }
            __syncthreads();
            if (tid < 32) out[O_LRUP + (size_t)b * D + chb + tid] = CARRY[tid];
            __syncthreads();
        }
        if (vcu < 256) {
            const int grp = vcu >> 3, n = vcu & 7, sq = tid >> 7, c = tid & 127, b = 4 * grp + sq, ch = 128 * n + c;
            LAS float* XC = (LAS float*)lds;
            float xp[7], xc[4];
#pragma unroll
            for (int k = 0; k < 3; ++k) xp[k] = state_conv[(size_t)(b * 3 + k) * D + ch];
#pragma unroll
            for (int t = 0; t < 4; ++t) xp[3 + t] = bf2f(XL[(size_t)(MP + 4 * b + t) * D + ch]);
            const float cbv = conv_b[ch], cw0 = conv_w[ch], cw1 = conv_w[D + ch], cw2 = conv_w[2 * D + ch], cw3 = conv_w[3 * D + ch];
#pragma unroll
            for (int t = 0; t < 4; ++t) { xc[t] = cbv + cw0 * xp[t] + cw1 * xp[t + 1] + cw2 * xp[t + 2] + cw3 * xp[t + 3]; XC[(sq * 4 + t) * 128 + c] = xc[t]; }
            __syncthreads();
            float da[4] = {0.f, 0.f, 0.f, 0.f}, dx[4] = {0.f, 0.f, 0.f, 0.f};
            const float* wa = lru_wa + (size_t)n * 128 * 128 + c; const float* wx = lru_wx + (size_t)n * 128 * 128 + c;
#pragma unroll 4
            for (int k = 0; k < 128; ++k) { const float a = wa[k * 128], x = wx[k * 128];
#pragma unroll
                for (int t = 0; t < 4; ++t) { const float xk = XC[(sq * 4 + t) * 128 + k]; da[t] += xk * a; dx[t] += xk * x; } }
            const float xl = -lru_lambda[ch]; const float cl = -8.f * (fmaxf(xl, 0.f) + log1pf(expf(-fabsf(xl)))); const float bav = lru_ba[ch], bxv = lru_bx[ch];
            float h = state_lru[(size_t)b * D + ch];
#pragma unroll
            for (int t = 0; t < 4; ++t) { const float r = sigm(da[t] + bav), ig = sigm(dx[t] + bxv), la = cl * r, a = __expf(la), mult = sqrtf(-expm1f(2.f * la));
                h = a * h + mult * ig * xc[t];
                bf16_t* pp = GL + (size_t)(MP + 4 * b + t) * D + ch; const float y = h * bf2f(*pp); *pp = (bf16_t)(cvt_pk_bf16(y, 0.f) & 0xffffu); }
            out[O_LRUS + (size_t)b * D + ch] = h;
            __syncthreads();
        }
    }
    xcd_barrier(bar);

    {
        pg8::Gemm g{UG, GL, WBR, 1024, 2048, 32, 16}; pg8::StaticOrder S; S.init(M, D, G, bx);
        EpiG2 E{QR, GB, MRG};
        pg8::gemm_phase<EpiG2, true>(lds, lds + EPI_OFF, g, S, E);
    }
    xcd_barrier(bar);

    {
        pg8::Gemm g{PB, PB, WPLE, 256, 256, 4, 4}; pg8::StaticOrder S; S.init(M, D, G, bx);
        EpiF32 E{out};
        pg8::gemm_phase<EpiF32, true>(lds, lds + EPI_OFF, g, S, E);
    }
    {
        pg8::Gemm g{MRG, MRG, WOUT, 1024, 1024, 16, 16}; pg8::StaticOrder S; S.init(M, D, G, bx);
        EpiF32 E{X1F};
        pg8::gemm_phase<EpiF32, true>(lds, lds + EPI_OFF, g, S, E);
    }
    xcd_barrier(bar);

    {
        CArgs* KA = KARGS(); const float* x_prompt = KA->in[0]; const float* x_sample = KA->in[1]; const float* norm_post = KA->in[23];
        const int gw = vcu * NWAVES + wave, NGW = G * NWAVES;
        for (int m = gw; m < M; m += NGW) {
            const float* xrow = (m < MP) ? x_prompt + (size_t)m * D : x_sample + (size_t)(m - MP) * D;
            f32x4* orow = (f32x4*)(X1F + (size_t)m * D) + lane; f32x4 v[4]; float s = 0.f;
#pragma unroll
            for (int j = 0; j < 4; ++j) { v[j] = orow[64 * j]; s += (v[j][0] * v[j][0] + v[j][1] * v[j][1]) + (v[j][2] * v[j][2] + v[j][3] * v[j][3]); }
            const float rstd = 1.f / sqrtf(wave_sum(s) * (1.f / D) + EPS);
            u32x2* o8 = (u32x2*)(X1B + (size_t)m * D) + lane;
#pragma unroll
            for (int j = 0; j < 4; ++j) { const f32x4 gn = *((const f32x4*)norm_post + lane + 64 * j); const f32x4 xv = *((const f32x4*)xrow + lane + 64 * j); const f32x4 y = xv + v[j] * rstd * gn;
                orow[64 * j] = y; u32x2 w; w.x = cvt_pk_bf16(y[0], y[1]); w.y = cvt_pk_bf16(y[2], y[3]); o8[64 * j] = w; }
        }
    }
    xcd_barrier(bar);

    {
        CArgs* KA = KARGS(); const float* b_pg = KA->in[26];
        pg8::Gemm g{X1B, X1B, WPG, 1024, 1024, 16, 16}; pg8::StaticOrder S; S.init(M, D, G, bx);
        EpiFinal E{X1F, b_pg, out};
        pg8::gemm_phase<EpiFinal, true>(lds, lds + EPI_OFF, g, S, E);
    }
}

extern "C" void kernel_launch(void* const* d_in, const int* in_sizes, int n_in, void* d_out, int out_size, void* d_ws, size_t ws_size, hipStream_t stream) {
    static int grid = 0;
    if (grid == 0) {
        if (n_in != 27 || (size_t)out_size != O_END || ws_size < WS_END) { fprintf(stderr, "kernel_launch: unexpected shapes (n_in %d out %d ws %zu)\n", n_in, out_size, ws_size); grid = -1; return; }
        int dev = 0, cus = 0, per_cu = 0;
        if (hipGetDevice(&dev) != hipSuccess || hipDeviceGetAttribute(&cus, hipDeviceAttributeMultiprocessorCount, dev) != hipSuccess) { grid = -1; return; }
        if (hipFuncSetAttribute((const void*)mixer_fwd, hipFuncAttributeMaxDynamicSharedMemorySize, LDS_BYTES) != hipSuccess) { fprintf(stderr, "kernel_launch: hipFuncSetAttribute failed\n"); grid = -1; return; }
        if (hipOccupancyMaxActiveBlocksPerMultiprocessor(&per_cu, (const void*)mixer_fwd, NWAVES * 64, LDS_BYTES) != hipSuccess || per_cu < 1) { fprintf(stderr, "kernel_launch: occupancy query says %d\n", per_cu); per_cu = 1; }
        (void)hipGetLastError();
        grid = cus;
        if (grid > 256) grid = 256;
    }
    if (grid < 0) return;
    (void)hipMemsetAsync((char*)d_ws + WS_CTL, 0, CTL_ZERO_BYTES, stream);
    Args a{};
    for (int i = 0; i < 27; ++i) a.in[i] = (const float*)d_in[i];
    a.out = (float*)d_out; a.ws = (unsigned char*)d_ws;
    hipLaunchKernelGGL(mixer_fwd, dim3(grid), dim3(NWAVES * 64), LDS_BYTES, stream, a);
}
```

```cpp
#include <hip/hip_runtime.h>
#include <cstdio>
#include <cstdint>

#define LAS __attribute__((address_space(3)))
#define GAS __attribute__((address_space(1)))
typedef unsigned short bf16_t;
typedef short bf16x8 __attribute__((ext_vector_type(8)));
typedef short s16x4 __attribute__((ext_vector_type(4)));
typedef float f32x4 __attribute__((ext_vector_type(4)));
typedef float f32x2 __attribute__((ext_vector_type(2)));
typedef unsigned u32x4 __attribute__((ext_vector_type(4)));
typedef unsigned u32x2 __attribute__((ext_vector_type(2)));
typedef GAS unsigned gu32;

constexpr int D = 1024, MP = 16384, MS = 512, M = MP + MS, SEQ = 2048, NBATCH = 8, DBATCH = 128, PLE = 256;
constexpr int NIN = 7168;
constexpr float EPS = 1e-6f;
constexpr size_t O_Y = 0, O_CONVP = (size_t)M * D, O_LRUP = O_CONVP + 8 * 3 * 1024, O_CONVS = O_LRUP + 8 * 1024, O_LRUS = O_CONVS + 128 * 3 * 1024, O_CHV = O_LRUS + 128 * 1024, O_END = O_CHV + 128 * 4 * 1024;

constexpr size_t MiB = 1u << 20;
constexpr size_t WS_CTL = 0, CTL_ZERO_BYTES = 256 * 1024;
constexpr size_t WS_WIN = 1 * MiB, WS_WBR = 15 * MiB, WS_WOUT = 19 * MiB, WS_WPG = 21 * MiB, WS_WPLE = 23 * MiB, WS_LWA = 23 * MiB + 512 * 1024, WS_LWX = WS_LWA + 256 * 1024, WS_SGW = 24 * MiB;
constexpr size_t WS_PB = 25 * MiB;
constexpr size_t RSZ = 33 * MiB;
constexpr size_t WS_R0 = 36 * MiB, WS_R1 = WS_R0 + RSZ, WS_R2 = WS_R1 + RSZ, WS_R3 = WS_R2 + RSZ, WS_R4 = WS_R3 + RSZ, WS_R5 = WS_R4 + RSZ, WS_END = WS_R5 + RSZ;
static_assert(WS_END <= 256 * MiB, "ws map");
static_assert((size_t)M * D * 2 <= RSZ, "region size");
constexpr int CW_BAR = 1024;

constexpr int RING_BYTES = 131072, EPI_OFF = RING_BYTES, EPI_BYTES = 4096, MISC_OFF = EPI_OFF + EPI_BYTES, LDS_BYTES = 147456;
constexpr int NWAVES = 8;

__device__ __forceinline__ unsigned cvt_pk_bf16(float lo, float hi) { unsigned r; asm volatile("v_cvt_pk_bf16_f32 %0, %1, %2" : "=v"(r) : "v"(lo), "v"(hi)); return r; }
__device__ __forceinline__ float bf_lo(unsigned w) { return __builtin_bit_cast(float, w << 16); }
__device__ __forceinline__ float bf_hi(unsigned w) { return __builtin_bit_cast(float, w & 0xffff0000u); }
__device__ __forceinline__ float bf2f(bf16_t h) { return __builtin_bit_cast(float, (unsigned)h << 16); }
__device__ __forceinline__ float sigm(float x) { return __builtin_amdgcn_rcpf(1.f + __builtin_amdgcn_exp2f(-1.44269504089f * x)); }
__device__ __forceinline__ float wave_sum(float v) {
#pragma unroll
    for (int o = 1; o < 64; o <<= 1) v += __shfl_xor(v, o);
    return v;
}
#define LDS_WAIT() asm volatile("s_waitcnt lgkmcnt(0)" ::: "memory")
#define VM_WAIT() asm volatile("s_waitcnt vmcnt(0)" ::: "memory")

namespace pg8 {
constexpr int BM = 256, BK = 64, HALF = 128, HTB = HALF * BK * 2, NXCD = 8, WGM = 8;
__host__ __device__ __forceinline__ int lds_byte(int r, int c) { const int st = (r >> 4) * 2 + (c >> 5), rr = r & 15, cc = c & 31, ob = rr * 64 + cc * 2; return st * 1024 + (ob ^ (((ob >> 9) & 1) << 5)); }
__host__ __device__ __forceinline__ void stage_rc(int b, int& R, int& C) { const int st = b / 1024, sb = b % 1024, swz = sb ^ (((sb >> 9) & 1) << 5); R = (st >> 1) * 16 + swz / 64; C = (st & 1) * 32 + (swz % 64) / 2; }
__host__ __device__ __forceinline__ int perm32(int rho) { const int n = rho >> 4, i = rho & 15; return 8 * (i >> 2) + 4 * n + (i & 3); }
struct Unit { int pm, pn; };
struct Gemm { const bf16_t* A; const bf16_t* A2; const bf16_t* Bt; int lda, ldb, nt, ks; };
struct StaticOrder {
    int nM, nN, nwg, G, c;
    __device__ void init(int M_, int N_, int G_, int c_) { nM = M_ / BM; nN = N_ / BM; nwg = nM * nN; G = G_; c = c_; }
    __device__ bool next(int i, Unit& u) const {
        const long L = (long)i * G + c; if (L >= nwg) return false;
        int wgid = (int)L; { const int q = nwg / NXCD, r = nwg % NXCD, xcd = wgid % NXCD, off = wgid / NXCD; wgid = (xcd < r ? xcd * (q + 1) : r * (q + 1) + (xcd - r) * q) + off; }
        const int nig = WGM * nN, gid = wgid / nig, fm = gid * WGM, gsz = (nM - fm) < WGM ? (nM - fm) : WGM;
        u.pm = fm + ((wgid % nig) % gsz); u.pn = (wgid % nig) / gsz; return true;
    }
};
__device__ __forceinline__ const char* a_tile(const Gemm& g, int pm, int kt) {
    const bool first = kt < g.ks; const bf16_t* base = first ? g.A : g.A2; const int kk = first ? kt : kt - g.ks;
    return (const char*)base + ((size_t)pm * BM * g.lda + (size_t)kk * BK) * 2;
}
__device__ __forceinline__ const char* b_tile(const Gemm& g, int pn, int kt) { return (const char*)g.Bt + ((size_t)pn * BM * g.ldb + (size_t)kt * BK) * 2; }

template <class Epi, bool ALIGN_EPI>
__device__ __forceinline__ void gemm_phase(LAS unsigned char* lds, LAS unsigned char* epi_lds, const Gemm g, const StaticOrder& S, const Epi& E) {
    int tid_ = threadIdx.x; asm volatile("" : "+v"(tid_));
    const int tid = tid_, wid = __builtin_amdgcn_readfirstlane(tid >> 6), lane = tid & 63, wr = wid >> 2, wc = wid & 3, fr = lane & 15, fq = lane >> 4;
    const int nt = g.nt;
    unsigned voffA[2], voffB[2];
#pragma unroll
    for (int i = 0; i < 2; ++i) { int R, C; stage_rc(tid * 16 + i * 8192, R, C); const int Rb = Epi::PERM ? ((R & ~31) + perm32(R & 31)) : R;
        voffA[i] = (unsigned)(R * g.lda + C) * 2u; voffB[i] = (unsigned)(Rb * g.ldb + C) * 2u; }
    const size_t hstepA = (size_t)HALF * g.lda * 2, hstepB = (size_t)HALF * g.ldb * 2;
    const unsigned ldsw = (unsigned)wid * 1024u;
    const int aoff = lds_byte(wr * 64 + fr, fq * 8), boff = lds_byte(wc * 32 + fr, fq * 8);
#define PG8_SA(b, h) (((b) * 2 + (h)) * HTB)
#define PG8_SB(b, h) ((4 + (b) * 2 + (h)) * HTB)
#define PG8_STAGE(bufoff, gbase, voff) do { _Pragma("unroll") for (int _i = 0; _i < 2; ++_i) \
        __builtin_amdgcn_global_load_lds((const unsigned*)((const char*)(gbase) + (voff)[_i]), (LAS unsigned*)(lds + (bufoff) + ldsw + _i * 8192), 16, 0, 0); } while (0)
#define PG8_LDA(dst, b, h) do { _Pragma("unroll") for (int m = 0; m < 4; ++m) _Pragma("unroll") for (int k = 0; k < 2; ++k) dst[m][k] = *(const LAS bf16x8*)(lds + PG8_SA(b, h) + aoff + m * 2048 + k * 1024); } while (0)
#define PG8_LDB(dst, b, h) do { _Pragma("unroll") for (int n = 0; n < 2; ++n) _Pragma("unroll") for (int k = 0; k < 2; ++k) dst[n][k] = *(const LAS bf16x8*)(lds + PG8_SB(b, h) + boff + n * 2048 + k * 1024); } while (0)
#define PG8_MMA(ai, bj, At, Bt) do { __builtin_amdgcn_s_setprio(1); _Pragma("unroll") for (int m = 0; m < 4; ++m) _Pragma("unroll") for (int n = 0; n < 2; ++n) _Pragma("unroll") for (int k = 0; k < 2; ++k) \
        acc[ai][bj][m][n] = __builtin_amdgcn_mfma_f32_16x16x32_bf16(Bt[n][k], At[m][k], acc[ai][bj][m][n], 0, 0, 0); __builtin_amdgcn_s_setprio(0); } while (0)
#define PG8_WAIT_V(n) asm volatile("s_waitcnt vmcnt(" #n ")" ::: "memory")
#define PG8_WAIT_L(n) asm volatile("s_waitcnt lgkmcnt(" #n ")" ::: "memory")
#define PG8_BAR __builtin_amdgcn_s_barrier()
#define PG8_SCHED __builtin_amdgcn_sched_barrier(0)
    Unit cur, nxt; int ui = 0;
    if (!S.next(0, cur)) return;
    f32x4 acc[2][2][4][2];
#pragma unroll
    for (int a = 0; a < 2; ++a)
#pragma unroll
        for (int b = 0; b < 2; ++b)
#pragma unroll
            for (int m = 0; m < 4; ++m)
#pragma unroll
                for (int n = 0; n < 2; ++n) acc[a][b][m][n] = (f32x4){0.f, 0.f, 0.f, 0.f};
    bf16x8 At[4][2], B0[2][2], B1[2][2];
    {
        const char* cA = a_tile(g, cur.pm, 0); const char* cB = b_tile(g, cur.pn, 0); const char* cA1 = a_tile(g, cur.pm, 1); const char* cB1 = b_tile(g, cur.pn, 1);
        PG8_STAGE(PG8_SB(0, 0), cB, voffB); PG8_STAGE(PG8_SB(0, 1), cB + hstepB, voffB); PG8_STAGE(PG8_SA(0, 0), cA, voffA); PG8_STAGE(PG8_SA(0, 1), cA + hstepA, voffA);
        if (wr == 1) PG8_BAR;
        PG8_WAIT_V(2); PG8_BAR;
        PG8_STAGE(PG8_SB(1, 0), cB1, voffB); PG8_STAGE(PG8_SA(1, 0), cA1, voffA); PG8_STAGE(PG8_SB(1, 1), cB1 + hstepB, voffB);
        PG8_WAIT_V(6); PG8_BAR;
    }
    for (;;) {
        const bool has_next = S.next(ui + 1, nxt);
        const Unit nu = has_next ? nxt : cur;
        for (int t = 0; t < nt; t += 2) {
            const bool last = (t == nt - 2);
            if constexpr (Epi::HAS_MID) { if (t == g.ks) E.mid(acc, cur, wr, wc, fr, fq); }
            const char* a1 = a_tile(g, cur.pm, t + 1);
            const char* a2 = last ? a_tile(g, nu.pm, 0) : a_tile(g, cur.pm, t + 2); const char* b2 = last ? b_tile(g, nu.pn, 0) : b_tile(g, cur.pn, t + 2);
            const char* a3 = last ? a_tile(g, nu.pm, 1) : a_tile(g, cur.pm, t + 3); const char* b3 = last ? b_tile(g, nu.pn, 1) : b_tile(g, cur.pn, t + 3);
            PG8_LDB(B0, 0, 0); PG8_LDB(B1, 0, 1); PG8_SCHED; PG8_LDA(At, 0, 0); PG8_STAGE(PG8_SA(1, 1), a1 + hstepA, voffA);
            PG8_WAIT_V(8); PG8_WAIT_L(0); PG8_BAR; PG8_MMA(0, 0, At, B0); PG8_MMA(0, 1, At, B1); PG8_BAR; PG8_SCHED;
            PG8_LDA(At, 0, 1); PG8_STAGE(PG8_SB(0, 0), b2, voffB); PG8_STAGE(PG8_SB(0, 1), b2 + hstepB, voffB); PG8_STAGE(PG8_SA(0, 0), a2, voffA);
            PG8_WAIT_V(8); PG8_WAIT_L(0); PG8_BAR; PG8_MMA(1, 0, At, B0); PG8_MMA(1, 1, At, B1); PG8_BAR; PG8_SCHED;
            PG8_LDB(B0, 1, 0); PG8_LDB(B1, 1, 1); PG8_SCHED; PG8_LDA(At, 1, 0); PG8_STAGE(PG8_SA(0, 1), a2 + hstepA, voffA);
            PG8_WAIT_V(8); PG8_WAIT_L(0); PG8_BAR; PG8_MMA(0, 0, At, B0); PG8_MMA(0, 1, At, B1); PG8_BAR; PG8_SCHED;
            PG8_LDA(At, 1, 1); PG8_STAGE(PG8_SB(1, 0), b3, voffB); PG8_STAGE(PG8_SB(1, 1), b3 + hstepB, voffB); PG8_STAGE(PG8_SA(1, 0), a3, voffA);
            PG8_WAIT_V(8); PG8_WAIT_L(0); PG8_BAR; PG8_MMA(1, 0, At, B0); PG8_MMA(1, 1, At, B1); PG8_BAR; PG8_SCHED;
        }
        if constexpr (ALIGN_EPI) { if (wr == 0) PG8_BAR; }
        E(acc, cur, wr, wc, fr, fq, epi_lds);
        if (!has_next) break;
#pragma unroll
        for (int a = 0; a < 2; ++a)
#pragma unroll
            for (int b = 0; b < 2; ++b)
#pragma unroll
                for (int m = 0; m < 4; ++m)
#pragma unroll
                    for (int n = 0; n < 2; ++n) acc[a][b][m][n] = (f32x4){0.f, 0.f, 0.f, 0.f};
        cur = nxt; ++ui;
        if constexpr (ALIGN_EPI) { if (wr == 1) PG8_BAR; }
    }
    PG8_WAIT_V(0);
    if constexpr (!ALIGN_EPI) { if (wr == 0) PG8_BAR; }
    PG8_BAR;
#undef PG8_SA
#undef PG8_SB
#undef PG8_STAGE
#undef PG8_LDA
#undef PG8_LDB
#undef PG8_MMA
#undef PG8_WAIT_V
#undef PG8_WAIT_L
#undef PG8_BAR
#undef PG8_SCHED
}
}
using pg8::Unit;

struct EpiG1 {
    static constexpr bool PERM = true, HAS_MID = false;
    bf16_t *UG, *Z, *XL, *GL, *QR, *GB; const float* sgn; const float* bmerge; float* out;
    __device__ __forceinline__ void mid(f32x4 (&)[2][2][4][2], const Unit&, int, int, int, int) const {}
    __device__ __forceinline__ void operator()(f32x4 (&acc)[2][2][4][2], const Unit& u, int wr, int wc, int fr, int fq, LAS unsigned char* el) const {
        const int row0 = u.pm * 256 + wr * 64 + fr, cw = wc * 32 + 8 * fq, pn = u.pn;
        if (pn < 8) {
#pragma unroll
            for (int ai = 0; ai < 2; ++ai)
#pragma unroll
                for (int m = 0; m < 4; ++m) { const int row = row0 + ai * 128 + m * 16; float v[8];
#pragma unroll
                    for (int n = 0; n < 2; ++n)
#pragma unroll
                        for (int j = 0; j < 4; ++j) { const float uu = acc[ai][0][m][n][j], gg = acc[ai][1][m][n][j]; v[4 * n + j] = uu * gg * sigm(gg); }
                    u32x4 w; w.x = cvt_pk_bf16(v[0], v[1]); w.y = cvt_pk_bf16(v[2], v[3]); w.z = cvt_pk_bf16(v[4], v[5]); w.w = cvt_pk_bf16(v[6], v[7]);
                    *(u32x4*)(UG + (size_t)row * D + pn * 128 + cw) = w; }
        } else if (pn < 12) {
            const int h = pn - 8; LAS float* P = (LAS float*)el;
#pragma unroll
            for (int ai = 0; ai < 2; ++ai)
#pragma unroll
                for (int m = 0; m < 4; ++m) { float s = 0.f;
#pragma unroll
                    for (int bj = 0; bj < 2; ++bj)
#pragma unroll
                        for (int n = 0; n < 2; ++n) { const f32x4 x = acc[ai][bj][m][n]; s += (x[0] * x[0] + x[1] * x[1]) + (x[2] * x[2] + x[3] * x[3]); }
                    s += __shfl_xor(s, 16); s += __shfl_xor(s, 32);
                    if (fq == 0) P[(ai * 128 + wr * 64 + m * 16 + fr) * 4 + wc] = s; }
            asm volatile("s_waitcnt lgkmcnt(0)" ::: "memory"); __builtin_amdgcn_s_barrier(); asm volatile("" ::: "memory");
            f32x4 gn[2][2];
#pragma unroll
            for (int bj = 0; bj < 2; ++bj)
#pragma unroll
                for (int n = 0; n < 2; ++n) gn[bj][n] = *(const f32x4*)(sgn + h * 256 + bj * 128 + cw + 4 * n);
#pragma unroll
            for (int ai = 0; ai < 2; ++ai)
#pragma unroll
                for (int m = 0; m < 4; ++m) { const int lr = ai * 128 + wr * 64 + m * 16 + fr, row = u.pm * 256 + lr;
                    const f32x4 p4 = *(const LAS f32x4*)(P + lr * 4); const float rstd = __builtin_amdgcn_rsqf(((p4[0] + p4[1]) + (p4[2] + p4[3])) * (1.f / 256.f) + EPS);
#pragma unroll
                    for (int bj = 0; bj < 2; ++bj) { const f32x4 z0 = acc[ai][bj][m][0] * rstd * gn[bj][0], z1 = acc[ai][bj][m][1] * rstd * gn[bj][1];
                        u32x4 w; w.x = cvt_pk_bf16(z0[0], z0[1]); w.y = cvt_pk_bf16(z0[2], z0[3]); w.z = cvt_pk_bf16(z1[0], z1[1]); w.w = cvt_pk_bf16(z1[2], z1[3]);
                        const int col = h * 256 + bj * 128 + cw;
                        *(u32x4*)(Z + (size_t)row * D + col) = w;
                        if (row >= MP) { float* o = out + O_CHV + (size_t)(row - MP) * D + col; *(f32x4*)o = z0; *(f32x4*)(o + 4) = z1; } } }
            asm volatile("s_waitcnt lgkmcnt(0)" ::: "memory"); __builtin_amdgcn_s_barrier(); asm volatile("" ::: "memory");
        } else if (pn < 16) {
#pragma unroll
            for (int ai = 0; ai < 2; ++ai)
#pragma unroll
                for (int m = 0; m < 4; ++m) { const int row = row0 + ai * 128 + m * 16;
                    float* cdst = nullptr;
                    if (row < MP) { const int t = row & (SEQ - 1); if (t >= SEQ - 3) cdst = out + O_CONVP + (size_t)((row >> 11) * 3 + (t - (SEQ - 3))) * D; }
                    else { const int rs = row - MP, t = rs & 3; if (t >= 1) cdst = out + O_CONVS + (size_t)((rs >> 2) * 3 + (t - 1)) * D; }
#pragma unroll
                    for (int bj = 0; bj < 2; ++bj) { const f32x4 z0 = acc[ai][bj][m][0], z1 = acc[ai][bj][m][1];
                        u32x4 w; w.x = cvt_pk_bf16(z0[0], z0[1]); w.y = cvt_pk_bf16(z0[2], z0[3]); w.z = cvt_pk_bf16(z1[0], z1[1]); w.w = cvt_pk_bf16(z1[2], z1[3]);
                        const int col = (pn - 12) * 256 + bj * 128 + cw;
                        *(u32x4*)(XL + (size_t)row * D + col) = w;
                        if (cdst) { *(f32x4*)(cdst + col) = z0; *(f32x4*)(cdst + col + 4) = z1; } } }
        } else if (pn < 20) {
#pragma unroll
            for (int ai = 0; ai < 2; ++ai)
#pragma unroll
                for (int m = 0; m < 4; ++m) { const int row = row0 + ai * 128 + m * 16;
#pragma unroll
                    for (int bj = 0; bj < 2; ++bj) { float v[8];
#pragma unroll
                        for (int n = 0; n < 2; ++n)
#pragma unroll
                            for (int j = 0; j < 4; ++j) { const float gg = acc[ai][bj][m][n][j]; v[4 * n + j] = gg * sigm(gg); }
                        u32x4 w; w.x = cvt_pk_bf16(v[0], v[1]); w.y = cvt_pk_bf16(v[2], v[3]); w.z = cvt_pk_bf16(v[4], v[5]); w.w = cvt_pk_bf16(v[6], v[7]);
                        *(u32x4*)(GL + (size_t)row * D + (pn - 16) * 256 + bj * 128 + cw) = w; } }
        } else {
            const int c0 = (pn - 20) * 128 + cw;
            f32x4 ba[2], bb[2];
#pragma unroll
            for (int n = 0; n < 2; ++n) { ba[n] = *(const f32x4*)(bmerge + c0 + 4 * n); bb[n] = *(const f32x4*)(bmerge + D + c0 + 4 * n); }
#pragma unroll
            for (int ai = 0; ai < 2; ++ai)
#pragma unroll
                for (int m = 0; m < 4; ++m) { const int row = row0 + ai * 128 + m * 16; float q[8], gbv[8];
#pragma unroll
                    for (int n = 0; n < 2; ++n)
#pragma unroll
                        for (int j = 0; j < 4; ++j) { const float a = acc[ai][0][m][n][j] + ba[n][j], b = acc[ai][1][m][n][j] + bb[n][j];
                            const float eb = __builtin_amdgcn_exp2f(-1.44269504089f * b); const float ga = sigm(a);
                            gbv[4 * n + j] = fmaxf(__builtin_amdgcn_rcpf(1.f + eb), 1e-30f); q[4 * n + j] = fminf(ga * (1.f + eb), 3.0e38f); }
                    u32x4 w; w.x = cvt_pk_bf16(q[0], q[1]); w.y = cvt_pk_bf16(q[2], q[3]); w.z = cvt_pk_bf16(q[4], q[5]); w.w = cvt_pk_bf16(q[6], q[7]);
                    *(u32x4*)(QR + (size_t)row * D + c0) = w;
                    w.x = cvt_pk_bf16(gbv[0], gbv[1]); w.y = cvt_pk_bf16(gbv[2], gbv[3]); w.z = cvt_pk_bf16(gbv[4], gbv[5]); w.w = cvt_pk_bf16(gbv[6], gbv[7]);
                    *(u32x4*)(GB + (size_t)row * D + c0) = w; }
        }
    }
};
struct EpiG2 {
    static constexpr bool PERM = true, HAS_MID = true;
    const bf16_t *QR, *GB; bf16_t* MRG;
    __device__ __forceinline__ void mid(f32x4 (&acc)[2][2][4][2], const Unit& u, int wr, int wc, int fr, int fq) const {
        unsigned off0 = (unsigned)((u.pm * 256 + wr * 64 + fr) * D + u.pn * 256 + wc * 32 + 8 * fq) * 2u; asm volatile("" : "+v"(off0));
#pragma unroll
        for (int ai = 0; ai < 2; ++ai)
#pragma unroll
            for (int m = 0; m < 4; ++m) {
#pragma unroll
                for (int bj = 0; bj < 2; ++bj) { const u32x4 q = *(const u32x4*)((const char*)QR + (off0 + (unsigned)(((ai * 128 + m * 16) * D + bj * 128) * 2)));
                    acc[ai][bj][m][0] *= (f32x4){bf_lo(q.x), bf_hi(q.x), bf_lo(q.y), bf_hi(q.y)}; acc[ai][bj][m][1] *= (f32x4){bf_lo(q.z), bf_hi(q.z), bf_lo(q.w), bf_hi(q.w)}; }
                if (m & 1) asm volatile("" ::: "memory"); }
    }
    __device__ __forceinline__ void operator()(f32x4 (&acc)[2][2][4][2], const Unit& u, int wr, int wc, int fr, int fq, LAS unsigned char*) const {
        unsigned off0 = (unsigned)((u.pm * 256 + wr * 64 + fr) * D + u.pn * 256 + wc * 32 + 8 * fq) * 2u; asm volatile("" : "+v"(off0));
#pragma unroll
        for (int ai = 0; ai < 2; ++ai)
#pragma unroll
            for (int m = 0; m < 4; ++m) {
#pragma unroll
                for (int bj = 0; bj < 2; ++bj) { const unsigned off = off0 + (unsigned)(((ai * 128 + m * 16) * D + bj * 128) * 2); const u32x4 q = *(const u32x4*)((const char*)GB + off);
                    const f32x4 v0 = acc[ai][bj][m][0] * (f32x4){bf_lo(q.x), bf_hi(q.x), bf_lo(q.y), bf_hi(q.y)}, v1 = acc[ai][bj][m][1] * (f32x4){bf_lo(q.z), bf_hi(q.z), bf_lo(q.w), bf_hi(q.w)};
                    u32x4 w; w.x = cvt_pk_bf16(v0[0], v0[1]); w.y = cvt_pk_bf16(v0[2], v0[3]); w.z = cvt_pk_bf16(v1[0], v1[1]); w.w = cvt_pk_bf16(v1[2], v1[3]);
                    *(u32x4*)((char*)MRG + off) = w; }
                if (m & 1) asm volatile("" ::: "memory"); }
    }
};
struct EpiF32 {
    static constexpr bool PERM = false, HAS_MID = false;
    float* dst;
    __device__ __forceinline__ void mid(f32x4 (&)[2][2][4][2], const Unit&, int, int, int, int) const {}
    __device__ __forceinline__ void operator()(f32x4 (&acc)[2][2][4][2], const Unit& u, int wr, int wc, int fr, int fq, LAS unsigned char*) const {
        const int row0 = u.pm * 256 + wr * 64 + fr, c0 = u.pn * 256 + wc * 32 + 4 * fq;
#pragma unroll
        for (int ai = 0; ai < 2; ++ai)
#pragma unroll
            for (int m = 0; m < 4; ++m)
#pragma unroll
                for (int bj = 0; bj < 2; ++bj)
#pragma unroll
                    for (int n = 0; n < 2; ++n) *(f32x4*)(dst + (size_t)(row0 + ai * 128 + m * 16) * D + c0 + bj * 128 + n * 16) = acc[ai][bj][m][n];
    }
};
struct EpiFinal {
    static constexpr bool PERM = false, HAS_MID = false;
    const float* X1F; const float* bias; float* out;
    __device__ __forceinline__ void mid(f32x4 (&)[2][2][4][2], const Unit&, int, int, int, int) const {}
    __device__ __forceinline__ void operator()(f32x4 (&acc)[2][2][4][2], const Unit& u, int wr, int wc, int fr, int fq, LAS unsigned char*) const {
        const int row0 = u.pm * 256 + wr * 64 + fr, c0 = u.pn * 256 + wc * 32 + 4 * fq;
#pragma unroll
        for (int bj = 0; bj < 2; ++bj)
#pragma unroll
            for (int n = 0; n < 2; ++n) { const f32x4 bv = *(const f32x4*)(bias + c0 + bj * 128 + n * 16);
#pragma unroll
                for (int ai = 0; ai < 2; ++ai)
#pragma unroll
                    for (int m = 0; m < 4; ++m) { const size_t off = (size_t)(row0 + ai * 128 + m * 16) * D + c0 + bj * 128 + n * 16;
                        const f32x4 x1 = *(const f32x4*)(X1F + off), e = *(const f32x4*)(out + off), a = acc[ai][bj][m][n] + bv;
                        f32x4 o; o[0] = x1[0] + sigm(a[0]) * e[0]; o[1] = x1[1] + sigm(a[1]) * e[1]; o[2] = x1[2] + sigm(a[2]) * e[2]; o[3] = x1[3] + sigm(a[3]) * e[3];
                        *(f32x4*)(out + off) = o; } }
    }
};

#define XB_TMO      128
#define XB_XCNT(j)  (256  + 64 * (j))
#define XB_XSUB(j)  (1280 + 64 * (j))
#define XB_XGEN(j)  (2304 + 64 * (j))
#define XB_TOP      3328
#define XB_TOPGEN   3392
#define XCD_BAR_WORDS 3456
#define XB_SPIN_CAP (1u << 18)
__device__ __forceinline__ unsigned xb_ld(unsigned* p)              { return __hip_atomic_load(p, __ATOMIC_RELAXED, __HIP_MEMORY_SCOPE_AGENT); }
__device__ __forceinline__ unsigned xb_add(unsigned* p, unsigned v) { return __hip_atomic_fetch_add(p, v, __ATOMIC_RELAXED, __HIP_MEMORY_SCOPE_AGENT); }
__device__ __forceinline__ unsigned xb_xcc_id() { return (unsigned)__builtin_amdgcn_s_getreg((3 << 11) | 20) & 0xFu; }
#define XB_SPIN(cond, bar) do { unsigned _sp = 0; while (cond) { __builtin_amdgcn_s_sleep(1); \
    if ((++_sp & 255u) == 0u) { if (xb_ld(&(bar)[XB_TMO])) break; if (_sp > XB_SPIN_CAP) { atomicAdd(&(bar)[XB_TMO], 1u); break; } } } } while (0)
struct XcdBarrier { unsigned* bar; unsigned x; volatile LAS unsigned* st; };
__device__ __forceinline__ XcdBarrier xcd_barrier_post(unsigned* bar, volatile LAS unsigned* st) {
    XcdBarrier b; b.bar = bar; b.x = xb_xcc_id(); b.st = st;
    if (threadIdx.x == 0) (void)xb_add(&bar[XB_XCNT(b.x)], 1u);
    return b;
}
__device__ __forceinline__ void xcd_barrier_complete(unsigned* bar, unsigned x, unsigned& nloc, unsigned& nx) {
    const unsigned G = gridDim.x * gridDim.y * gridDim.z;
    unsigned sum, cnt, mine, sp = 0u;
    for (;;) {
        sum = 0u; cnt = 0u; mine = 0u;
#pragma unroll
        for (unsigned j = 0; j < 16; ++j) { const unsigned c = xb_ld(&bar[XB_XCNT(j)]); sum += c; cnt += (c > 0u) ? 1u : 0u; mine = (j == x) ? c : mine; }
        if (sum == G) break;
        __builtin_amdgcn_s_sleep(1);
        if ((++sp & 255u) == 0u) { if (xb_ld(&bar[XB_TMO])) break; if (sp > XB_SPIN_CAP) { atomicAdd(&bar[XB_TMO], 1u); break; } }
    }
    nloc = mine > 0u ? mine : 1u; nx = cnt > 0u ? cnt : 1u;
}
__device__ __forceinline__ void xcd_barrier(const XcdBarrier& b) {
    asm volatile("s_waitcnt vmcnt(0)" ::: "memory");
    __syncthreads();
    if (threadIdx.x == 0) {
        unsigned* bar = b.bar;
        __builtin_amdgcn_s_waitcnt(0);
        unsigned nloc = b.st[0], nx = b.st[1];
        if (nloc == 0u) { xcd_barrier_complete(bar, b.x, nloc, nx); b.st[0] = nloc; b.st[1] = nx; }
        const unsigned old = xb_add(&bar[XB_XSUB(b.x)], 1u);
        const unsigned gen = old / nloc;
        if (old + 1u == (gen + 1u) * nloc) {
            __builtin_amdgcn_fence(__ATOMIC_RELEASE, "agent");
            asm volatile("s_waitcnt vmcnt(0)" ::: "memory");
            const unsigned og = xb_add(&bar[XB_TOP], 1u);
            const unsigned tg = og / nx;
            if (og + 1u == (tg + 1u) * nx) xb_add(&bar[XB_TOPGEN], 1u);
            else XB_SPIN(xb_ld(&bar[XB_TOPGEN]) == tg, bar);
            __builtin_amdgcn_fence(__ATOMIC_ACQUIRE, "agent");
            xb_add(&bar[XB_XGEN(b.x)], 1u);
            asm volatile("s_waitcnt vmcnt(0)" ::: "memory");
        } else {
            XB_SPIN(xb_ld(&bar[XB_XGEN(b.x)]) == gen, bar);
            __builtin_amdgcn_fence(__ATOMIC_ACQUIRE, "agent");
            asm volatile("s_waitcnt vmcnt(0)" ::: "memory");
        }
    }
    __syncthreads();
}

__device__ __forceinline__ void p0_transpose_item(const float* W, int Nsrc, int scol0, int k0, bf16_t* WT, int ldd, int drow0, int dk0, LAS float* scr, int lane) {
#pragma unroll 8
    for (int i = 0; i < 32; ++i) { const int kk = 2 * i + (lane >> 5); scr[kk * 33 + (lane & 31)] = W[(size_t)(k0 + kk) * Nsrc + scol0 + (lane & 31)]; }
    LDS_WAIT(); asm volatile("" ::: "memory");
    const int c = lane & 7;
#pragma unroll
    for (int j = 0; j < 4; ++j) { const int n = (lane >> 3) + 8 * j; const LAS float* s = scr + (8 * c) * 33 + n;
        u32x4 o; o.x = cvt_pk_bf16(s[0 * 33], s[1 * 33]); o.y = cvt_pk_bf16(s[2 * 33], s[3 * 33]); o.z = cvt_pk_bf16(s[4 * 33], s[5 * 33]); o.w = cvt_pk_bf16(s[6 * 33], s[7 * 33]);
        *(u32x4*)(WT + (size_t)(drow0 + n) * ldd + dk0 + 8 * c) = o; }
    LDS_WAIT(); asm volatile("" ::: "memory");
}

#ifndef PROBE_PHASE
#define PROBE_PHASE -1
#endif
struct Args { const float* in[27]; float* out; unsigned char* ws; int pad0, pad1; };

__global__ void __launch_bounds__(NWAVES * 64, 2) mixer_fwd(Args args) {
    extern __shared__ __attribute__((aligned(16))) unsigned char lds_raw[];
    LAS unsigned char* lds = (LAS unsigned char*)lds_raw;
    volatile LAS unsigned* MISC = (volatile LAS unsigned*)(lds + MISC_OFF);
    const int tid = threadIdx.x, lane = tid & 63, wave = __builtin_amdgcn_readfirstlane(tid >> 6);
    const int G = gridDim.x; const int bx = blockIdx.x; const int vcu = (G % 8 == 0) ? (bx % 8) * (G / 8) + bx / 8 : bx;
    typedef const Args __attribute__((address_space(4))) CArgs;
    CArgs* const args_c = (CArgs*)__builtin_amdgcn_kernarg_segment_ptr();
#define KARGS() ({ CArgs* _p = args_c; asm volatile("" : "+s"(_p)); _p; })
    unsigned char* ws; float* out; { CArgs* A = KARGS(); ws = A->ws; out = A->out; }
    bf16_t* WIN = (bf16_t*)(ws + WS_WIN); bf16_t* WBR = (bf16_t*)(ws + WS_WBR); bf16_t* WOUT = (bf16_t*)(ws + WS_WOUT); bf16_t* WPG = (bf16_t*)(ws + WS_WPG); bf16_t* WPLE = (bf16_t*)(ws + WS_WPLE);
    bf16_t* LWA = (bf16_t*)(ws + WS_LWA); bf16_t* LWX = (bf16_t*)(ws + WS_LWX); bf16_t* SGW = (bf16_t*)(ws + WS_SGW); bf16_t* PB = (bf16_t*)(ws + WS_PB);
    bf16_t* H = (bf16_t*)out;
    bf16_t* UG = (bf16_t*)(ws + WS_R0); bf16_t* Z = (bf16_t*)(ws + WS_R1); bf16_t* XL = (bf16_t*)(ws + WS_R2); bf16_t* GL = (bf16_t*)(ws + WS_R3); bf16_t* QR = (bf16_t*)(ws + WS_R4); bf16_t* GB = (bf16_t*)(ws + WS_R5);
    bf16_t* MRG = (bf16_t*)(ws + WS_R1);
    float* X1F = (float*)(ws + WS_R4);
    bf16_t* X1B = (bf16_t*)(ws + WS_R0);

    for (int u = tid; u < (LDS_BYTES - MISC_OFF) / 4; u += NWAVES * 64) ((LAS unsigned*)(lds + MISC_OFF))[u] = 0u;
    __syncthreads();
    XcdBarrier bar = xcd_barrier_post((unsigned*)(ws + WS_CTL) + CW_BAR, MISC + 8);
    unsigned long long pr_t0 = 0, pr_t1 = 0; int pr_n = 0;
#define STAMP() do { if (PROBE_PHASE >= 0) { const unsigned long long _t = __builtin_amdgcn_s_memrealtime(); if (pr_n == PROBE_PHASE) pr_t0 = _t; if (pr_n == PROBE_PHASE + 1) pr_t1 = _t; ++pr_n; } } while (0)
    STAMP();

    {
        CArgs* KA = KARGS();
        const float* x_prompt = KA->in[0]; const float* x_sample = KA->in[1]; const float* p_prompt = KA->in[2]; const float* p_sample = KA->in[3]; const float* norm_pre = KA->in[6]; const float* w_in = KA->in[7];
        const float* sg_w = KA->in[9]; const float* lru_wa = KA->in[13]; const float* lru_wx = KA->in[15]; const float* w_br_sg = KA->in[18]; const float* w_br_lru = KA->in[19]; const float* w_merge = KA->in[20];
        const float* w_out = KA->in[22]; const float* w_ple = KA->in[24]; const float* w_pg = KA->in[25];
        LAS float* scr = (LAS float*)(lds + wave * 16384);
        const int gw = vcu * NWAVES + wave, NGW = G * NWAVES;
        constexpr int I_WIN = (NIN / 32) * 16, I_WBR = 32 * 32, I_WOUT = 32 * 16, I_WPG = 32 * 16, I_WPLE = 32 * 4, I_LRU = 2 * 8 * 4 * 2;
        constexpr int NITEMS = I_WIN + I_WBR + I_WOUT + I_WPG + I_WPLE + I_LRU;
        for (int it = gw; it < NITEMS; it += NGW) {
            int r = it;
            if (r < I_WIN) { const int rb = r >> 4, kb = r & 15, pn = rb >> 3, q = rb & 7; const float* src; int ns, sc;
                if (pn < 8)       { src = w_in; ns = 5120; sc = (q < 4) ? (pn * 128 + q * 32) : (2048 + pn * 128 + (q - 4) * 32); }
                else if (pn < 12) { src = w_in; ns = 5120; sc = 1024 + (pn - 8) * 256 + q * 32; }
                else if (pn < 16) { src = w_in; ns = 5120; sc = 3072 + (pn - 12) * 256 + q * 32; }
                else if (pn < 20) { src = w_in; ns = 5120; sc = 4096 + (pn - 16) * 256 + q * 32; }
                else              { src = w_merge; ns = 2048; sc = (q < 4) ? ((pn - 20) * 128 + q * 32) : (1024 + (pn - 20) * 128 + (q - 4) * 32); }
                p0_transpose_item(src, ns, sc, kb * 64, WIN, 1024, rb * 32, kb * 64, scr, lane); continue; }
            r -= I_WIN;
            if (r < I_WBR) { const int rb = r >> 5, kb = r & 31; const float* src = kb < 16 ? w_br_sg : w_br_lru;
                p0_transpose_item(src, 1024, rb * 32, (kb & 15) * 64, WBR, 2048, rb * 32, kb * 64, scr, lane); continue; }
            r -= I_WBR;
            if (r < I_WOUT) { const int rb = r >> 4, kb = r & 15; p0_transpose_item(w_out, 1024, rb * 32, kb * 64, WOUT, 1024, rb * 32, kb * 64, scr, lane); continue; }
            r -= I_WOUT;
            if (r < I_WPG) { const int rb = r >> 4, kb = r & 15; p0_transpose_item(w_pg, 1024, rb * 32, kb * 64, WPG, 1024, rb * 32, kb * 64, scr, lane); continue; }
            r -= I_WPG;
            if (r < I_WPLE) { const int rb = r >> 2, kb = r & 3; p0_transpose_item(w_ple, 1024, rb * 32, kb * 64, WPLE, 256, rb * 32, kb * 64, scr, lane); continue; }
            r -= I_WPLE;
            { const int g = r >> 6, n = (r >> 3) & 7, rb = (r >> 1) & 3, kb = r & 1;
              p0_transpose_item((g ? lru_wx : lru_wa) + (size_t)n * 128 * 128, 128, rb * 32, kb * 64, (g ? LWX : LWA) + (size_t)n * 128 * 128, 128, rb * 32, kb * 64, scr, lane); }
        }
        for (int i = vcu * 512 + tid; i < 4 * 128 * 128; i += G * 512) { const int t = (i >> 7) & 127, s = i & 127; const float v = (s <= t) ? sg_w[i] : 0.f; SGW[i] = (bf16_t)(cvt_pk_bf16(v, 0.f) & 0xffffu); }
        for (int m = gw; m < M; m += NGW) {
            const float* xrow = (m < MP) ? x_prompt + (size_t)m * D : x_sample + (size_t)(m - MP) * D;
            const f32x4* xr = (const f32x4*)xrow + lane; f32x4 v[4]; float s = 0.f;
#pragma unroll
            for (int j = 0; j < 4; ++j) { v[j] = xr[64 * j]; s += (v[j][0] * v[j][0] + v[j][1] * v[j][1]) + (v[j][2] * v[j][2] + v[j][3] * v[j][3]); }
            const float rstd = 1.f / sqrtf(wave_sum(s) * (1.f / D) + EPS);
            u32x2* o8 = (u32x2*)(H + (size_t)m * D) + lane;
#pragma unroll
            for (int j = 0; j < 4; ++j) { const f32x4 gn = *((const f32x4*)norm_pre + lane + 64 * j); const f32x4 y = v[j] * rstd * gn;
                u32x2 w; w.x = cvt_pk_bf16(y[0], y[1]); w.y = cvt_pk_bf16(y[2], y[3]); o8[64 * j] = w; }
        }
        for (int i = vcu * 512 + tid; i < M * PLE / 8; i += G * 512) { const int row = i >> 5, c8 = i & 31;
            const float* src = (row < MP ? p_prompt + (size_t)row * PLE : p_sample + (size_t)(row - MP) * PLE) + c8 * 8;
            const f32x4 a = *(const f32x4*)src, b = *(const f32x4*)(src + 4);
            u32x4 w; w.x = cvt_pk_bf16(a[0], a[1]); w.y = cvt_pk_bf16(a[2], a[3]); w.z = cvt_pk_bf16(b[0], b[1]); w.w = cvt_pk_bf16(b[2], b[3]);
            *(u32x4*)(PB + (size_t)row * PLE + c8 * 8) = w; }
    }
    xcd_barrier(bar); STAMP();

    {
        CArgs* KA = KARGS(); const float* sg_norm = KA->in[8]; const float* b_merge = KA->in[21];
        pg8::Gemm g{H, H, WIN, 1024, 1024, 16, 16}; pg8::StaticOrder S; S.init(M, NIN, G, bx);
        EpiG1 E{UG, Z, XL, GL, QR, GB, sg_norm, b_merge, out};
        pg8::gemm_phase<EpiG1, true>(lds, lds + EPI_OFF, g, S, E);
    }
    xcd_barrier(bar); STAMP();

    {
        CArgs* KA = KARGS();
        const float* state_conv = KA->in[4]; const float* state_lru = KA->in[5]; const float* sg_w = KA->in[9]; const float* sg_b = KA->in[10]; const float* conv_w = KA->in[11]; const float* conv_b = KA->in[12];
        const float* lru_wa = KA->in[13]; const float* lru_ba = KA->in[14]; const float* lru_wx = KA->in[15]; const float* lru_bx = KA->in[16]; const float* lru_lambda = KA->in[17];
        const int fr = lane & 15, fq = lane >> 4;
        {
            LAS unsigned char* Zs = lds; LAS unsigned char* Ws = lds + 69632;
#pragma unroll 1
            for (int it = 0; it < 2; ++it) {
                const int item = 2 * vcu + it, c = item >> 2, h = item & 3, r0 = c * 128;
#pragma unroll
                for (int j = 0; j < 8; ++j) { const int idx = tid + 512 * j, row = idx >> 5, c16 = idx & 31;
                    *(LAS u32x4*)(Zs + row * 544 + 16 * c16) = *(const u32x4*)(Z + (size_t)(r0 + row) * D + 256 * h + 8 * c16); }
#pragma unroll
                for (int j = 0; j < 4; ++j) { const int idx = tid + 512 * j, row = idx >> 4, c16 = idx & 15;
                    *(LAS u32x4*)(Ws + row * 272 + 16 * c16) = *(const u32x4*)(SGW + (size_t)(h * 128 + row) * 128 + 8 * c16); }
                unsigned ugoff = (unsigned)((r0 + fr) * D + 256 * h + 32 * wave + 4 * fq) * 2u; asm volatile("" : "+v"(ugoff));
                u32x2 ugv[8][2];
#pragma unroll
                for (int tb = 0; tb < 8; ++tb)
#pragma unroll
                    for (int dbi = 0; dbi < 2; ++dbi) ugv[tb][dbi] = *(const u32x2*)((const char*)UG + (ugoff + (unsigned)((16 * tb * D + 16 * dbi) * 2)));
                __syncthreads();
                f32x4 acc[2][8];
#pragma unroll
                for (int a2 = 0; a2 < 2; ++a2)
#pragma unroll
                    for (int b2 = 0; b2 < 8; ++b2) acc[a2][b2] = (f32x4){0.f, 0.f, 0.f, 0.f};
#pragma unroll
                for (int ks = 0; ks < 4; ++ks) { const int k0 = 32 * ks; bf16x8 zf[2];
#pragma unroll
                    for (int dbi = 0; dbi < 2; ++dbi) { const int d0 = 16 * (2 * wave + dbi);
                        LAS unsigned char* a0 = Zs + (k0 + 8 * fq + (fr >> 2)) * 544 + (d0 + 4 * (fr & 3)) * 2;
                        const s16x4 lo = __builtin_bit_cast(s16x4, __builtin_amdgcn_ds_read_tr16_b64_v4i16((LAS s16x4*)a0));
                        const s16x4 hi = __builtin_bit_cast(s16x4, __builtin_amdgcn_ds_read_tr16_b64_v4i16((LAS s16x4*)(a0 + 4 * 544)));
                        zf[dbi] = (bf16x8){lo[0], lo[1], lo[2], lo[3], hi[0], hi[1], hi[2], hi[3]}; }
#pragma unroll
                    for (int tb = 0; tb < 8; ++tb) if (tb >= 2 * ks) { const bf16x8 wf = *(const LAS bf16x8*)(Ws + (16 * tb + fr) * 272 + (k0 + 8 * fq) * 2);
                        acc[0][tb] = __builtin_amdgcn_mfma_f32_16x16x32_bf16(zf[0], wf, acc[0][tb], 0, 0, 0); acc[1][tb] = __builtin_amdgcn_mfma_f32_16x16x32_bf16(zf[1], wf, acc[1][tb], 0, 0, 0); } }
                asm volatile("" : "+v"(ugoff));
#pragma unroll
                for (int tb = 0; tb < 8; ++tb) { const float bias = sg_b[h * 128 + 16 * tb + fr];
#pragma unroll
                    for (int dbi = 0; dbi < 2; ++dbi) { const u32x2 ug = ugv[tb][dbi];
                        u32x2 w; w.x = cvt_pk_bf16(bf_lo(ug.x) * (acc[dbi][tb][0] + bias), bf_hi(ug.x) * (acc[dbi][tb][1] + bias)); w.y = cvt_pk_bf16(bf_lo(ug.y) * (acc[dbi][tb][2] + bias), bf_hi(ug.y) * (acc[dbi][tb][3] + bias));
                        *(u32x2*)((char*)UG + (ugoff + (unsigned)((16 * tb * D + 16 * dbi) * 2))) = w; } }
                __syncthreads();
            }
        }
        for (int idx = vcu * 512 + tid; idx < DBATCH * 128; idx += G * 512) { const int b = idx >> 7, col = (idx & 127) * 8, h = col >> 8;
            float zr[4][8];
#pragma unroll
            for (int s = 0; s < 4; ++s) { const u32x4 q = *(const u32x4*)(Z + (size_t)(MP + 4 * b + s) * D + col);
                zr[s][0] = bf_lo(q.x); zr[s][1] = bf_hi(q.x); zr[s][2] = bf_lo(q.y); zr[s][3] = bf_hi(q.y); zr[s][4] = bf_lo(q.z); zr[s][5] = bf_hi(q.z); zr[s][6] = bf_lo(q.w); zr[s][7] = bf_hi(q.w); }
#pragma unroll
            for (int t = 0; t < 4; ++t) { float sv[8]; const float bias = sg_b[h * 128 + t];
#pragma unroll
                for (int j = 0; j < 8; ++j) sv[j] = bias;
#pragma unroll
                for (int s = 0; s <= t; ++s) { const float w = sg_w[(size_t)(h * 128 + t) * 128 + s];
#pragma unroll
                    for (int j = 0; j < 8; ++j) sv[j] += w * zr[s][j]; }
                bf16_t* pp = UG + (size_t)(MP + 4 * b + t) * D + col; const u32x4 q = *(const u32x4*)pp;
                u32x4 w; w.x = cvt_pk_bf16(bf_lo(q.x) * sv[0], bf_hi(q.x) * sv[1]); w.y = cvt_pk_bf16(bf_lo(q.y) * sv[2], bf_hi(q.y) * sv[3]); w.z = cvt_pk_bf16(bf_lo(q.z) * sv[4], bf_hi(q.z) * sv[5]); w.w = cvt_pk_bf16(bf_lo(q.w) * sv[6], bf_hi(q.w) * sv[7]);
                *(u32x4*)pp = w; } }
        {
            const int b = vcu >> 5, sl = vcu & 31, n = sl >> 2, sub = sl & 3, chb = 128 * n + 32 * sub;
            LAS unsigned char* Xs = lds; LAS unsigned char* XCs = lds + 35840; LAS f32x2* AB = (LAS f32x2*)(lds + 70656);
            LAS float* CH = (LAS float*)(lds + 107520);
            bf16x8 wfr[2][2][4];
#pragma unroll
            for (int g = 0; g < 2; ++g)
#pragma unroll
                for (int cb = 0; cb < 2; ++cb)
#pragma unroll
                    for (int ks = 0; ks < 4; ++ks) wfr[g][cb][ks] = *(const bf16x8*)((g ? LWX : LWA) + (size_t)(n * 128 + 32 * sub + 16 * cb + fr) * 128 + 32 * ks + 8 * fq);
            if (tid < 32) { const int ch = chb + tid; const float xl = -lru_lambda[ch];
                const float sp = fmaxf(xl, 0.f) + log1pf(expf(-fabsf(xl)));
                CH[tid * 8 + 0] = lru_ba[ch]; CH[tid * 8 + 1] = lru_bx[ch]; CH[tid * 8 + 2] = -8.f * sp; CH[tid * 8 + 3] = conv_b[ch];
                CH[tid * 8 + 4] = conv_w[ch]; CH[tid * 8 + 5] = conv_w[D + ch]; CH[tid * 8 + 6] = conv_w[2 * D + ch]; CH[tid * 8 + 7] = conv_w[3 * D + ch]; }
            const int kg = tid & 15; f32x4 cwv[4][2], cbv[2];
            cbv[0] = *(const f32x4*)(conv_b + 128 * n + 8 * kg); cbv[1] = *(const f32x4*)(conv_b + 128 * n + 8 * kg + 4);
#pragma unroll
            for (int jj = 0; jj < 4; ++jj) { cwv[jj][0] = *(const f32x4*)(conv_w + jj * D + 128 * n + 8 * kg); cwv[jj][1] = *(const f32x4*)(conv_w + jj * D + 128 * n + 8 * kg + 4); }
            u32x4 xpf[5], gnext, gcur; const int orow = tid >> 2, opart = tid & 3;
            { const int r0 = b * SEQ;
#pragma unroll
              for (int k = 0; k < 5; ++k) { const int idx = tid + 512 * k, row = idx >> 4, c16 = idx & 15; xpf[k] = (u32x4){0u, 0u, 0u, 0u};
                  if (idx < 131 * 16 && row >= 3) xpf[k] = *(const u32x4*)(XL + (size_t)(r0 - 3 + row) * D + 128 * n + 8 * c16); }
              gnext = *(const u32x4*)(GL + (size_t)(r0 + orow) * D + chb + 8 * opart); }
            float carry = 0.f;
#pragma unroll 1
            for (int tc = 0; tc < 16; ++tc) {
                const int r0 = b * SEQ + 128 * tc;
#pragma unroll
                for (int k = 0; k < 5; ++k) { const int idx = tid + 512 * k, row = idx >> 4, c16 = idx & 15; if (idx < 131 * 16) *(LAS u32x4*)(Xs + row * 272 + 16 * c16) = xpf[k]; }
                gcur = gnext;
                if (tc < 15) { const int r1 = r0 + 128;
#pragma unroll
                    for (int k = 0; k < 5; ++k) { const int idx = tid + 512 * k, row = idx >> 4, c16 = idx & 15; if (idx < 131 * 16) xpf[k] = *(const u32x4*)(XL + (size_t)(r1 - 3 + row) * D + 128 * n + 8 * c16); }
                    gnext = *(const u32x4*)(GL + (size_t)(r1 + orow) * D + chb + 8 * opart); }
                __syncthreads();
#pragma unroll
                for (int it = 0; it < 4; ++it) { const int t = (tid >> 4) + 32 * it;
                    f32x4 a0 = cbv[0], a1 = cbv[1];
#pragma unroll
                    for (int jj = 0; jj < 4; ++jj) { const u32x4 q = *(const LAS u32x4*)(Xs + (t + jj) * 272 + 16 * kg);
                        a0 += cwv[jj][0] * (f32x4){bf_lo(q.x), bf_hi(q.x), bf_lo(q.y), bf_hi(q.y)}; a1 += cwv[jj][1] * (f32x4){bf_lo(q.z), bf_hi(q.z), bf_lo(q.w), bf_hi(q.w)}; }
                    u32x4 w; w.x = cvt_pk_bf16(a0[0], a0[1]); w.y = cvt_pk_bf16(a0[2], a0[3]); w.z = cvt_pk_bf16(a1[0], a1[1]); w.w = cvt_pk_bf16(a1[2], a1[3]);
                    *(LAS u32x4*)(XCs + t * 272 + 16 * kg) = w; }
                __syncthreads();
                f32x4 ga[2][2];
#pragma unroll
                for (int g = 0; g < 2; ++g)
#pragma unroll
                    for (int cb = 0; cb < 2; ++cb) ga[g][cb] = (f32x4){0.f, 0.f, 0.f, 0.f};
#pragma unroll
                for (int ks = 0; ks < 4; ++ks) { const bf16x8 xf = *(const LAS bf16x8*)(XCs + (16 * wave + fr) * 272 + (32 * ks + 8 * fq) * 2);
#pragma unroll
                    for (int g = 0; g < 2; ++g)
#pragma unroll
                        for (int cb = 0; cb < 2; ++cb) ga[g][cb] = __builtin_amdgcn_mfma_f32_16x16x32_bf16(wfr[g][cb][ks], xf, ga[g][cb], 0, 0, 0); }
                { const int t = 16 * wave + fr, tp = t + (t >> 3);
#pragma unroll
                  for (int cb = 0; cb < 2; ++cb)
#pragma unroll
                      for (int j = 0; j < 4; ++j) { const int chl = 16 * cb + 4 * fq + j; const f32x4 k0 = *(const LAS f32x4*)(CH + chl * 8), k1 = *(const LAS f32x4*)(CH + chl * 8 + 4);
                          const float r = sigm(ga[0][cb][j] + k0[0]), ig = sigm(ga[1][cb][j] + k0[1]), la = k0[2] * r, a = __expf(la), x2 = 2.f * la;
                          const float em = (x2 > -0.3f) ? -x2 * (1.f + x2 * (0.5f + x2 * (0.16666667f + x2 * (0.041666668f + x2 * 0.0083333338f)))) : (1.f - __expf(x2));
                          const float mult = sqrtf(em);
                          const int kc = 32 * sub + chl;
                          float xcv = k0[3];
                          xcv += k1[0] * bf2f(*(const LAS bf16_t*)(Xs + (t + 0) * 272 + 2 * kc)); xcv += k1[1] * bf2f(*(const LAS bf16_t*)(Xs + (t + 1) * 272 + 2 * kc));
                          xcv += k1[2] * bf2f(*(const LAS bf16_t*)(Xs + (t + 2) * 272 + 2 * kc)); xcv += k1[3] * bf2f(*(const LAS bf16_t*)(Xs + (t + 3) * 272 + 2 * kc));
                          AB[chl * 144 + tp] = (f32x2){a, mult * ig * xcv}; } }
                __syncthreads();
                { const int chl = 4 * wave + (lane >> 4), seg = lane & 15; LAS f32x2* abp = AB + chl * 144 + 9 * seg;
                  f32x2 ab[8]; float A = 1.f, Hh = 0.f;
#pragma unroll
                  for (int i = 0; i < 8; ++i) { ab[i] = abp[i]; Hh = ab[i][0] * Hh + ab[i][1]; A *= ab[i][0]; }
#pragma unroll
                  for (int d = 1; d < 16; d <<= 1) { const float Ap = __shfl_up(A, d, 16), Hp = __shfl_up(Hh, d, 16); if (seg >= d) { Hh = A * Hp + Hh; A = A * Ap; } }
                  float Ae = __shfl_up(A, 1, 16), He = __shfl_up(Hh, 1, 16); if (seg == 0) { Ae = 1.f; He = 0.f; }
                  float h = Ae * carry + He;
                  const float hend = A * carry + Hh; carry = __shfl(hend, 15, 16);
#pragma unroll
                  for (int i = 0; i < 8; ++i) { h = ab[i][0] * h + ab[i][1]; abp[i] = (f32x2){h, 0.f}; } }
                __syncthreads();
                { const int tp = orow + (orow >> 3); float hv[8];
#pragma unroll
                  for (int j = 0; j < 8; ++j) hv[j] = AB[(8 * opart + j) * 144 + tp][0];
                  u32x4 w; w.x = cvt_pk_bf16(hv[0] * bf_lo(gcur.x), hv[1] * bf_hi(gcur.x)); w.y = cvt_pk_bf16(hv[2] * bf_lo(gcur.y), hv[3] * bf_hi(gcur.y));
                  w.z = cvt_pk_bf16(hv[4] * bf_lo(gcur.z), hv[5] * bf_hi(gcur.z)); w.w = cvt_pk_bf16(hv[6] * bf_lo(gcur.w), hv[7] * bf_hi(gcur.w));
                  *(u32x4*)(GL + (size_t)(r0 + orow) * D + chb + 8 * opart) = w; }
            }
            if ((lane & 15) == 0) out[O_LRUP + (size_t)b * D + chb + 4 * wave + (lane >> 4)] = carry;
            __syncthreads();
        }
        if (vcu < 256) {
            const int grp = vcu >> 3, n = vcu & 7, sq = tid >> 7, c = tid & 127, b = 4 * grp + sq, ch = 128 * n + c;
            LAS float* XC = (LAS float*)lds;
            float xp[7], xc[4];
#pragma unroll
            for (int k = 0; k < 3; ++k) xp[k] = state_conv[(size_t)(b * 3 + k) * D + ch];
#pragma unroll
            for (int t = 0; t < 4; ++t) xp[3 + t] = bf2f(XL[(size_t)(MP + 4 * b + t) * D + ch]);
            const float cbv = conv_b[ch], cw0 = conv_w[ch], cw1 = conv_w[D + ch], cw2 = conv_w[2 * D + ch], cw3 = conv_w[3 * D + ch];
#pragma unroll
            for (int t = 0; t < 4; ++t) { xc[t] = cbv + cw0 * xp[t] + cw1 * xp[t + 1] + cw2 * xp[t + 2] + cw3 * xp[t + 3]; XC[(sq * 4 + t) * 128 + c] = xc[t]; }
            __syncthreads();
            float da[4] = {0.f, 0.f, 0.f, 0.f}, dx[4] = {0.f, 0.f, 0.f, 0.f};
            const float* wa = lru_wa + (size_t)n * 128 * 128 + c; const float* wx = lru_wx + (size_t)n * 128 * 128 + c;
#pragma unroll 4
            for (int k = 0; k < 128; ++k) { const float a = wa[k * 128], x = wx[k * 128];
#pragma unroll
                for (int t = 0; t < 4; ++t) { const float xk = XC[(sq * 4 + t) * 128 + k]; da[t] += xk * a; dx[t] += xk * x; } }
            const float xl = -lru_lambda[ch]; const float cl = -8.f * (fmaxf(xl, 0.f) + log1pf(expf(-fabsf(xl)))); const float bav = lru_ba[ch], bxv = lru_bx[ch];
            float h = state_lru[(size_t)b * D + ch];
#pragma unroll
            for (int t = 0; t < 4; ++t) { const float r = sigm(da[t] + bav), ig = sigm(dx[t] + bxv), la = cl * r, a = __expf(la), mult = sqrtf(-expm1f(2.f * la));
                h = a * h + mult * ig * xc[t];
                bf16_t* pp = GL + (size_t)(MP + 4 * b + t) * D + ch; const float y = h * bf2f(*pp); *pp = (bf16_t)(cvt_pk_bf16(y, 0.f) & 0xffffu); }
            out[O_LRUS + (size_t)b * D + ch] = h;
            __syncthreads();
        }
    }
    xcd_barrier(bar); STAMP();

    {
        pg8::Gemm g{UG, GL, WBR, 1024, 2048, 32, 16}; pg8::StaticOrder S; S.init(M, D, G, bx);
        EpiG2 E{QR, GB, MRG};
        pg8::gemm_phase<EpiG2, true>(lds, lds + EPI_OFF, g, S, E);
    }
    xcd_barrier(bar); STAMP();

    {
        pg8::Gemm g{PB, PB, WPLE, 256, 256, 4, 4}; pg8::StaticOrder S; S.init(M, D, G, bx);
        EpiF32 E{out};
        pg8::gemm_phase<EpiF32, true>(lds, lds + EPI_OFF, g, S, E);
    }
    {
        pg8::Gemm g{MRG, MRG, WOUT, 1024, 1024, 16, 16}; pg8::StaticOrder S; S.init(M, D, G, bx);
        EpiF32 E{X1F};
        pg8::gemm_phase<EpiF32, true>(lds, lds + EPI_OFF, g, S, E);
    }
    xcd_barrier(bar); STAMP();

    {
        CArgs* KA = KARGS(); const float* x_prompt = KA->in[0]; const float* x_sample = KA->in[1]; const float* norm_post = KA->in[23];
        const int gw = vcu * NWAVES + wave, NGW = G * NWAVES;
        for (int m = gw; m < M; m += NGW) {
            const float* xrow = (m < MP) ? x_prompt + (size_t)m * D : x_sample + (size_t)(m - MP) * D;
            f32x4* orow = (f32x4*)(X1F + (size_t)m * D) + lane; f32x4 v[4]; float s = 0.f;
#pragma unroll
            for (int j = 0; j < 4; ++j) { v[j] = orow[64 * j]; s += (v[j][0] * v[j][0] + v[j][1] * v[j][1]) + (v[j][2] * v[j][2] + v[j][3] * v[j][3]); }
            const float rstd = 1.f / sqrtf(wave_sum(s) * (1.f / D) + EPS);
            u32x2* o8 = (u32x2*)(X1B + (size_t)m * D) + lane;
#pragma unroll
            for (int j = 0; j < 4; ++j) { const f32x4 gn = *((const f32x4*)norm_post + lane + 64 * j); const f32x4 xv = *((const f32x4*)xrow + lane + 64 * j); const f32x4 y = xv + v[j] * rstd * gn;
                orow[64 * j] = y; u32x2 w; w.x = cvt_pk_bf16(y[0], y[1]); w.y = cvt_pk_bf16(y[2], y[3]); o8[64 * j] = w; }
        }
    }
    xcd_barrier(bar); STAMP();

    {
        CArgs* KA = KARGS(); const float* b_pg = KA->in[26];
        pg8::Gemm g{X1B, X1B, WPG, 1024, 1024, 16, 16}; pg8::StaticOrder S; S.init(M, D, G, bx);
        EpiFinal E{X1F, b_pg, out};
        pg8::gemm_phase<EpiFinal, true>(lds, lds + EPI_OFF, g, S, E);
    }
    if (PROBE_PHASE >= 0) {
        xcd_barrier(bar); STAMP();
        if (bx == 0) { const float dt_us = (float)(pr_t1 - pr_t0) * 0.01f; const float sc = 1.01f + dt_us * 1e-4f;
            for (int i = tid; i < 8 * 3 * 1024; i += 512) out[O_CONVP + i] *= sc; }
    }
}

extern "C" void kernel_launch(void* const* d_in, const int* in_sizes, int n_in, void* d_out, int out_size, void* d_ws, size_t ws_size, hipStream_t stream) {
    static int grid = 0;
    if (grid == 0) {
        if (n_in != 27 || (size_t)out_size != O_END || ws_size < WS_END) { fprintf(stderr, "kernel_launch: unexpected shapes (n_in %d out %d ws %zu)\n", n_in, out_size, ws_size); grid = -1; return; }
        int dev = 0, cus = 0, per_cu = 0;
        if (hipGetDevice(&dev) != hipSuccess || hipDeviceGetAttribute(&cus, hipDeviceAttributeMultiprocessorCount, dev) != hipSuccess) { grid = -1; return; }
        if (hipFuncSetAttribute((const void*)mixer_fwd, hipFuncAttributeMaxDynamicSharedMemorySize, LDS_BYTES) != hipSuccess) { fprintf(stderr, "kernel_launch: hipFuncSetAttribute failed\n"); grid = -1; return; }
        if (hipOccupancyMaxActiveBlocksPerMultiprocessor(&per_cu, (const void*)mixer_fwd, NWAVES * 64, LDS_BYTES) != hipSuccess || per_cu < 1) { fprintf(stderr, "kernel_launch: occupancy query says %d\n", per_cu); per_cu = 1; }
        (void)hipGetLastError();
        grid = cus;
        if (grid > 256) grid = 256;
    }
    if (grid < 0) return;
    (void)hipMemsetAsync((char*)d_ws + WS_CTL, 0, CTL_ZERO_BYTES, stream);
    Args a{};
    for (int i = 0; i < 27; ++i) a.in[i] = (const float*)d_in[i];
    a.out = (float*)d_out; a.ws = (unsigned char*)d_ws;
    hipLaunchKernelGGL(mixer_fwd, dim3(grid), dim3(NWAVES * 64), LDS_BYTES, stream, a);
}
```

```cpp
#include <hip/hip_runtime.h>
#include <cstdio>
#include <cstdint>

#define LAS __attribute__((address_space(3)))
#define GAS __attribute__((address_space(1)))
typedef unsigned short bf16_t;
typedef short bf16x8 __attribute__((ext_vector_type(8)));
typedef short s16x4 __attribute__((ext_vector_type(4)));
typedef float f32x4 __attribute__((ext_vector_type(4)));
typedef float f32x2 __attribute__((ext_vector_type(2)));
typedef unsigned u32x4 __attribute__((ext_vector_type(4)));
typedef unsigned u32x2 __attribute__((ext_vector_type(2)));
typedef GAS unsigned gu32;

constexpr int D = 1024, MP = 16384, MS = 512, M = MP + MS, SEQ = 2048, NBATCH = 8, DBATCH = 128, PLE = 256;
constexpr int NIN = 7168;
constexpr float EPS = 1e-6f;
constexpr size_t O_Y = 0, O_CONVP = (size_t)M * D, O_LRUP = O_CONVP + 8 * 3 * 1024, O_CONVS = O_LRUP + 8 * 1024, O_LRUS = O_CONVS + 128 * 3 * 1024, O_CHV = O_LRUS + 128 * 1024, O_END = O_CHV + 128 * 4 * 1024;

constexpr size_t MiB = 1u << 20;
constexpr size_t WS_CTL = 0, CTL_ZERO_BYTES = 256 * 1024;
constexpr size_t WS_WIN = 1 * MiB, WS_WBR = 15 * MiB, WS_WOUT = 19 * MiB, WS_WPG = 21 * MiB, WS_WPLE = 23 * MiB, WS_LWA = 23 * MiB + 512 * 1024, WS_LWX = WS_LWA + 256 * 1024, WS_SGW = 24 * MiB;
constexpr size_t WS_PB = 25 * MiB;
constexpr size_t RSZ = 33 * MiB;
constexpr size_t WS_R0 = 36 * MiB, WS_R1 = WS_R0 + RSZ, WS_R2 = WS_R1 + RSZ, WS_R3 = WS_R2 + RSZ, WS_R4 = WS_R3 + RSZ, WS_R5 = WS_R4 + RSZ, WS_END = WS_R5 + RSZ;
static_assert(WS_END <= 256 * MiB, "ws map");
static_assert((size_t)M * D * 2 <= RSZ, "region size");
constexpr int CW_BAR = 1024;

constexpr int RING_BYTES = 131072, EPI_OFF = RING_BYTES, EPI_BYTES = 4096, MISC_OFF = EPI_OFF + EPI_BYTES, LDS_BYTES = 147456;
constexpr int NWAVES = 8;

__device__ __forceinline__ unsigned cvt_pk_bf16(float lo, float hi) { unsigned r; asm volatile("v_cvt_pk_bf16_f32 %0, %1, %2" : "=v"(r) : "v"(lo), "v"(hi)); return r; }
__device__ __forceinline__ float bf_lo(unsigned w) { return __builtin_bit_cast(float, w << 16); }
__device__ __forceinline__ float bf_hi(unsigned w) { return __builtin_bit_cast(float, w & 0xffff0000u); }
__device__ __forceinline__ float bf2f(bf16_t h) { return __builtin_bit_cast(float, (unsigned)h << 16); }
__device__ __forceinline__ float sigm(float x) { return __builtin_amdgcn_rcpf(1.f + __builtin_amdgcn_exp2f(-1.44269504089f * x)); }
__device__ __forceinline__ float wave_sum(float v) {
#pragma unroll
    for (int o = 1; o < 64; o <<= 1) v += __shfl_xor(v, o);
    return v;
}
#define LDS_WAIT() asm volatile("s_waitcnt lgkmcnt(0)" ::: "memory")
#define LBAR() do { asm volatile("s_waitcnt lgkmcnt(0)" ::: "memory"); __builtin_amdgcn_s_barrier(); asm volatile("" ::: "memory"); } while (0)
#define VM_WAIT() asm volatile("s_waitcnt vmcnt(0)" ::: "memory")

namespace pg8 {
constexpr int BM = 256, BK = 64, HALF = 128, HTB = HALF * BK * 2, NXCD = 8, WGM = 8;
__host__ __device__ __forceinline__ int lds_byte(int r, int c) { const int st = (r >> 4) * 2 + (c >> 5), rr = r & 15, cc = c & 31, ob = rr * 64 + cc * 2; return st * 1024 + (ob ^ (((ob >> 9) & 1) << 5)); }
__host__ __device__ __forceinline__ void stage_rc(int b, int& R, int& C) { const int st = b / 1024, sb = b % 1024, swz = sb ^ (((sb >> 9) & 1) << 5); R = (st >> 1) * 16 + swz / 64; C = (st & 1) * 32 + (swz % 64) / 2; }
__host__ __device__ __forceinline__ int perm32(int rho) { const int n = rho >> 4, i = rho & 15; return 8 * (i >> 2) + 4 * n + (i & 3); }
struct Unit { int pm, pn; };
struct Gemm { const bf16_t* A; const bf16_t* A2; const bf16_t* Bt; int lda, ldb, nt, ks; };
struct StaticOrder {
    int nM, nN, nwg, G, c;
    __device__ void init(int M_, int N_, int G_, int c_) { nM = M_ / BM; nN = N_ / BM; nwg = nM * nN; G = G_; c = c_; }
    __device__ bool next(int i, Unit& u) const {
        const long L = (long)i * G + c; if (L >= nwg) return false;
        int wgid = (int)L; { const int q = nwg / NXCD, r = nwg % NXCD, xcd = wgid % NXCD, off = wgid / NXCD; wgid = (xcd < r ? xcd * (q + 1) : r * (q + 1) + (xcd - r) * q) + off; }
        const int nig = WGM * nN, gid = wgid / nig, fm = gid * WGM, gsz = (nM - fm) < WGM ? (nM - fm) : WGM;
        u.pm = fm + ((wgid % nig) % gsz); u.pn = (wgid % nig) / gsz; return true;
    }
};
__device__ __forceinline__ const char* a_tile(const Gemm& g, int pm, int kt) {
    const bool first = kt < g.ks; const bf16_t* base = first ? g.A : g.A2; const int kk = first ? kt : kt - g.ks;
    return (const char*)base + ((size_t)pm * BM * g.lda + (size_t)kk * BK) * 2;
}
__device__ __forceinline__ const char* b_tile(const Gemm& g, int pn, int kt) { return (const char*)g.Bt + ((size_t)pn * BM * g.ldb + (size_t)kt * BK) * 2; }

template <class Epi, bool ALIGN_EPI>
__device__ __forceinline__ void gemm_phase(LAS unsigned char* lds, LAS unsigned char* epi_lds, const Gemm g, const StaticOrder& S, const Epi& E) {
    int tid_ = threadIdx.x; asm volatile("" : "+v"(tid_));
    const int tid = tid_, wid = __builtin_amdgcn_readfirstlane(tid >> 6), lane = tid & 63, wr = wid >> 2, wc = wid & 3, fr = lane & 15, fq = lane >> 4;
    const int nt = g.nt;
    unsigned voffA[2], voffB[2];
#pragma unroll
    for (int i = 0; i < 2; ++i) { int R, C; stage_rc(tid * 16 + i * 8192, R, C); const int Rb = Epi::PERM ? ((R & ~31) + perm32(R & 31)) : R;
        voffA[i] = (unsigned)(R * g.lda + C) * 2u; voffB[i] = (unsigned)(Rb * g.ldb + C) * 2u; }
    const size_t hstepA = (size_t)HALF * g.lda * 2, hstepB = (size_t)HALF * g.ldb * 2;
    const unsigned ldsw = (unsigned)wid * 1024u;
    const int aoff = lds_byte(wr * 64 + fr, fq * 8), boff = lds_byte(wc * 32 + fr, fq * 8);
#define PG8_SA(b, h) (((b) * 2 + (h)) * HTB)
#define PG8_SB(b, h) ((4 + (b) * 2 + (h)) * HTB)
#define PG8_STAGE(bufoff, gbase, voff) do { _Pragma("unroll") for (int _i = 0; _i < 2; ++_i) \
        __builtin_amdgcn_global_load_lds((const unsigned*)((const char*)(gbase) + (voff)[_i]), (LAS unsigned*)(lds + (bufoff) + ldsw + _i * 8192), 16, 0, 0); } while (0)
#define PG8_LDA(dst, b, h) do { _Pragma("unroll") for (int m = 0; m < 4; ++m) _Pragma("unroll") for (int k = 0; k < 2; ++k) dst[m][k] = *(const LAS bf16x8*)(lds + PG8_SA(b, h) + aoff + m * 2048 + k * 1024); } while (0)
#define PG8_LDB(dst, b, h) do { _Pragma("unroll") for (int n = 0; n < 2; ++n) _Pragma("unroll") for (int k = 0; k < 2; ++k) dst[n][k] = *(const LAS bf16x8*)(lds + PG8_SB(b, h) + boff + n * 2048 + k * 1024); } while (0)
#define PG8_MMA(ai, bj, At, Bt) do { __builtin_amdgcn_s_setprio(1); _Pragma("unroll") for (int m = 0; m < 4; ++m) _Pragma("unroll") for (int n = 0; n < 2; ++n) _Pragma("unroll") for (int k = 0; k < 2; ++k) \
        acc[ai][bj][m][n] = __builtin_amdgcn_mfma_f32_16x16x32_bf16(Bt[n][k], At[m][k], acc[ai][bj][m][n], 0, 0, 0); __builtin_amdgcn_s_setprio(0); } while (0)
#define PG8_WAIT_V(n) asm volatile("s_waitcnt vmcnt(" #n ")" ::: "memory")
#define PG8_WAIT_L(n) asm volatile("s_waitcnt lgkmcnt(" #n ")" ::: "memory")
#define PG8_BAR __builtin_amdgcn_s_barrier()
#define PG8_SCHED __builtin_amdgcn_sched_barrier(0)
    Unit cur, nxt; int ui = 0;
    if (!S.next(0, cur)) return;
    f32x4 acc[2][2][4][2];
#pragma unroll
    for (int a = 0; a < 2; ++a)
#pragma unroll
        for (int b = 0; b < 2; ++b)
#pragma unroll
            for (int m = 0; m < 4; ++m)
#pragma unroll
                for (int n = 0; n < 2; ++n) acc[a][b][m][n] = (f32x4){0.f, 0.f, 0.f, 0.f};
    bf16x8 At[4][2], B0[2][2], B1[2][2];
    {
        const char* cA = a_tile(g, cur.pm, 0); const char* cB = b_tile(g, cur.pn, 0); const char* cA1 = a_tile(g, cur.pm, 1); const char* cB1 = b_tile(g, cur.pn, 1);
        PG8_STAGE(PG8_SB(0, 0), cB, voffB); PG8_STAGE(PG8_SB(0, 1), cB + hstepB, voffB); PG8_STAGE(PG8_SA(0, 0), cA, voffA); PG8_STAGE(PG8_SA(0, 1), cA + hstepA, voffA);
        if (wr == 1) PG8_BAR;
        PG8_WAIT_V(2); PG8_BAR;
        PG8_STAGE(PG8_SB(1, 0), cB1, voffB); PG8_STAGE(PG8_SA(1, 0), cA1, voffA); PG8_STAGE(PG8_SB(1, 1), cB1 + hstepB, voffB);
        PG8_WAIT_V(6); PG8_BAR;
    }
    for (;;) {
        const bool has_next = S.next(ui + 1, nxt);
        const Unit nu = has_next ? nxt : cur;
        for (int t = 0; t < nt; t += 2) {
            const bool last = (t == nt - 2);
            if constexpr (Epi::HAS_MID) { if (t == g.ks) E.template mid<2, 2>(acc, cur.pm * 256, cur.pn, wr, wc, fr, fq); }
            const char* a1 = a_tile(g, cur.pm, t + 1);
            const char* a2 = last ? a_tile(g, nu.pm, 0) : a_tile(g, cur.pm, t + 2); const char* b2 = last ? b_tile(g, nu.pn, 0) : b_tile(g, cur.pn, t + 2);
            const char* a3 = last ? a_tile(g, nu.pm, 1) : a_tile(g, cur.pm, t + 3); const char* b3 = last ? b_tile(g, nu.pn, 1) : b_tile(g, cur.pn, t + 3);
            PG8_LDB(B0, 0, 0); PG8_LDB(B1, 0, 1); PG8_SCHED; PG8_LDA(At, 0, 0); PG8_STAGE(PG8_SA(1, 1), a1 + hstepA, voffA);
            PG8_WAIT_V(8); PG8_WAIT_L(0); PG8_BAR; PG8_MMA(0, 0, At, B0); PG8_MMA(0, 1, At, B1); PG8_BAR; PG8_SCHED;
            PG8_LDA(At, 0, 1); PG8_STAGE(PG8_SB(0, 0), b2, voffB); PG8_STAGE(PG8_SB(0, 1), b2 + hstepB, voffB); PG8_STAGE(PG8_SA(0, 0), a2, voffA);
            PG8_WAIT_V(8); PG8_WAIT_L(0); PG8_BAR; PG8_MMA(1, 0, At, B0); PG8_MMA(1, 1, At, B1); PG8_BAR; PG8_SCHED;
            PG8_LDB(B0, 1, 0); PG8_LDB(B1, 1, 1); PG8_SCHED; PG8_LDA(At, 1, 0); PG8_STAGE(PG8_SA(0, 1), a2 + hstepA, voffA);
            PG8_WAIT_V(8); PG8_WAIT_L(0); PG8_BAR; PG8_MMA(0, 0, At, B0); PG8_MMA(0, 1, At, B1); PG8_BAR; PG8_SCHED;
            PG8_LDA(At, 1, 1); PG8_STAGE(PG8_SB(1, 0), b3, voffB); PG8_STAGE(PG8_SB(1, 1), b3 + hstepB, voffB); PG8_STAGE(PG8_SA(1, 0), a3, voffA);
            PG8_WAIT_V(8); PG8_WAIT_L(0); PG8_BAR; PG8_MMA(1, 0, At, B0); PG8_MMA(1, 1, At, B1); PG8_BAR; PG8_SCHED;
        }
        if constexpr (ALIGN_EPI) { if (wr == 0) PG8_BAR; }
        E.template run<2, 2>(acc, cur.pm * 256, cur.pn, wr, wc, fr, fq, epi_lds);
        if (!has_next) break;
#pragma unroll
        for (int a = 0; a < 2; ++a)
#pragma unroll
            for (int b = 0; b < 2; ++b)
#pragma unroll
                for (int m = 0; m < 4; ++m)
#pragma unroll
                    for (int n = 0; n < 2; ++n) acc[a][b][m][n] = (f32x4){0.f, 0.f, 0.f, 0.f};
        cur = nxt; ++ui;
        if constexpr (ALIGN_EPI) { if (wr == 1) PG8_BAR; }
    }
    PG8_WAIT_V(0);
    if constexpr (!ALIGN_EPI) { if (wr == 0) PG8_BAR; }
    PG8_BAR;
#undef PG8_SA
#undef PG8_SB
#undef PG8_STAGE
#undef PG8_LDA
#undef PG8_LDB
#undef PG8_MMA
#undef PG8_WAIT_V
#undef PG8_WAIT_L
#undef PG8_BAR
#undef PG8_SCHED
}

template <class Epi, int NBJ>
__device__ __forceinline__ void gemm_sub(LAS unsigned char* lds, LAS unsigned char* epi_lds, const Gemm g, int arow0, int pn, const Epi& E) {
    int tid_ = threadIdx.x; asm volatile("" : "+v"(tid_));
    const int tid = tid_, wid = __builtin_amdgcn_readfirstlane(tid >> 6), lane = tid & 63, wr = wid >> 2, wc = wid & 3, fr = lane & 15, fq = lane >> 4;
    const int nt = g.nt;
    unsigned voffA[2], voffB[2];
#pragma unroll
    for (int i = 0; i < 2; ++i) { int R, C; stage_rc(tid * 16 + i * 8192, R, C); const int Rb = Epi::PERM ? ((R & ~31) + perm32(R & 31)) : R;
        voffA[i] = (unsigned)(R * g.lda + C) * 2u; voffB[i] = (unsigned)(Rb * g.ldb + C) * 2u; }
    const size_t hstepB = (size_t)HALF * g.ldb * 2;
    const unsigned ldsw = (unsigned)wid * 1024u;
    const int aoff = lds_byte(wr * 64 + fr, fq * 8), boff = lds_byte(wc * 32 + fr, fq * 8);
    const int brow0 = pn * HALF * NBJ;
    f32x4 acc[2][2][4][2];
#pragma unroll
    for (int b = 0; b < 2; ++b)
#pragma unroll
        for (int m = 0; m < 4; ++m)
#pragma unroll
            for (int n = 0; n < 2; ++n) acc[0][b][m][n] = (f32x4){0.f, 0.f, 0.f, 0.f};
#define SUB_SA(b) ((b) * HTB)
#define SUB_SB(b, j) ((2 + (b) * 2 + (j)) * HTB)
#define SUB_STAGE1(bufoff, gptr, voff) do { _Pragma("unroll") for (int _i = 0; _i < 2; ++_i) \
        __builtin_amdgcn_global_load_lds((const unsigned*)((gptr) + (voff)[_i]), (LAS unsigned*)(lds + (bufoff) + ldsw + _i * 8192), 16, 0, 0); } while (0)
#define SUB_STAGE(b, kt) do { const bool _f = (kt) < g.ks; const char* _a = (const char*)(_f ? g.A : g.A2) + ((size_t)arow0 * g.lda + (size_t)(_f ? (kt) : (kt) - g.ks) * BK) * 2; \
        const char* _b = (const char*)g.Bt + ((size_t)brow0 * g.ldb + (size_t)(kt) * BK) * 2; \
        SUB_STAGE1(SUB_SA(b), _a, voffA); SUB_STAGE1(SUB_SB(b, 0), _b, voffB); if (NBJ == 2) SUB_STAGE1(SUB_SB(b, 1), _b + hstepB, voffB); } while (0)
    SUB_STAGE(0, 0);
    for (int t = 0; t < nt; ++t) {
        const int b = t & 1;
        if (t + 1 < nt) { SUB_STAGE(b ^ 1, t + 1); if (NBJ == 2) asm volatile("s_waitcnt vmcnt(6)" ::: "memory"); else asm volatile("s_waitcnt vmcnt(4)" ::: "memory"); }
        else asm volatile("s_waitcnt vmcnt(0)" ::: "memory");
        __builtin_amdgcn_s_barrier(); asm volatile("" ::: "memory");
        if constexpr (Epi::HAS_MID) { if (t == g.ks) E.template mid<1, NBJ>(acc, arow0, pn, wr, wc, fr, fq); }
        bf16x8 At[4][2], B0[2][2], B1[2][2];
#pragma unroll
        for (int m = 0; m < 4; ++m)
#pragma unroll
            for (int k = 0; k < 2; ++k) At[m][k] = *(const LAS bf16x8*)(lds + SUB_SA(b) + aoff + m * 2048 + k * 1024);
#pragma unroll
        for (int n = 0; n < 2; ++n)
#pragma unroll
            for (int k = 0; k < 2; ++k) { B0[n][k] = *(const LAS bf16x8*)(lds + SUB_SB(b, 0) + boff + n * 2048 + k * 1024); if (NBJ == 2) B1[n][k] = *(const LAS bf16x8*)(lds + SUB_SB(b, 1) + boff + n * 2048 + k * 1024); }
#pragma unroll
        for (int m = 0; m < 4; ++m)
#pragma unroll
            for (int n = 0; n < 2; ++n)
#pragma unroll
                for (int k = 0; k < 2; ++k) { acc[0][0][m][n] = __builtin_amdgcn_mfma_f32_16x16x32_bf16(B0[n][k], At[m][k], acc[0][0][m][n], 0, 0, 0);
                    if (NBJ == 2) acc[0][1][m][n] = __builtin_amdgcn_mfma_f32_16x16x32_bf16(B1[n][k], At[m][k], acc[0][1][m][n], 0, 0, 0); }
        asm volatile("s_waitcnt lgkmcnt(0)" ::: "memory"); __builtin_amdgcn_s_barrier(); asm volatile("" ::: "memory");
    }
    E.template run<1, NBJ>(acc, arow0, pn, wr, wc, fr, fq, epi_lds);
    asm volatile("s_waitcnt lgkmcnt(0)" ::: "memory"); __builtin_amdgcn_s_barrier(); asm volatile("" ::: "memory");
#undef SUB_SA
#undef SUB_SB
#undef SUB_STAGE1
#undef SUB_STAGE
}
}
using pg8::Unit;

struct EpiG1 {
    static constexpr bool PERM = true, HAS_MID = false;
    bf16_t *UG, *Z, *XL, *GL, *QR, *GB; const float* sgn; const float* bmerge; float* out;
    template <int NAI, int NBJ> __device__ __forceinline__ void mid(f32x4 (&)[2][2][4][2], int, int, int, int, int, int) const {}
    template <int NAI, int NBJ> __device__ __forceinline__ void run(f32x4 (&acc)[2][2][4][2], int rowbase, int pn, int wr, int wc, int fr, int fq, LAS unsigned char* el) const {
        static_assert(NBJ == 2, "GEMM1 tiles are 256 columns wide");
        const int row0 = rowbase + wr * 64 + fr, cw = wc * 32 + 8 * fq;
        if (pn < 8) {
#pragma unroll
            for (int ai = 0; ai < NAI; ++ai)
#pragma unroll
                for (int m = 0; m < 4; ++m) { const int row = row0 + ai * 128 + m * 16; float v[8];
#pragma unroll
                    for (int n = 0; n < 2; ++n)
#pragma unroll
                        for (int j = 0; j < 4; ++j) { const float uu = acc[ai][0][m][n][j], gg = acc[ai][1][m][n][j]; v[4 * n + j] = uu * gg * sigm(gg); }
                    u32x4 w; w.x = cvt_pk_bf16(v[0], v[1]); w.y = cvt_pk_bf16(v[2], v[3]); w.z = cvt_pk_bf16(v[4], v[5]); w.w = cvt_pk_bf16(v[6], v[7]);
                    *(u32x4*)(UG + (size_t)row * D + pn * 128 + cw) = w; }
        } else if (pn < 12) {
            const int h = pn - 8; LAS float* P = (LAS float*)el;
#pragma unroll
            for (int ai = 0; ai < NAI; ++ai)
#pragma unroll
                for (int m = 0; m < 4; ++m) { float s = 0.f;
#pragma unroll
                    for (int bj = 0; bj < 2; ++bj)
#pragma unroll
                        for (int n = 0; n < 2; ++n) { const f32x4 x = acc[ai][bj][m][n]; s += (x[0] * x[0] + x[1] * x[1]) + (x[2] * x[2] + x[3] * x[3]); }
                    s += __shfl_xor(s, 16); s += __shfl_xor(s, 32);
                    if (fq == 0) P[(ai * 128 + wr * 64 + m * 16 + fr) * 4 + wc] = s; }
            asm volatile("s_waitcnt lgkmcnt(0)" ::: "memory"); __builtin_amdgcn_s_barrier(); asm volatile("" ::: "memory");
            f32x4 gn[2][2];
#pragma unroll
            for (int bj = 0; bj < 2; ++bj)
#pragma unroll
                for (int n = 0; n < 2; ++n) gn[bj][n] = *(const f32x4*)(sgn + h * 256 + bj * 128 + cw + 4 * n);
#pragma unroll
            for (int ai = 0; ai < NAI; ++ai)
#pragma unroll
                for (int m = 0; m < 4; ++m) { const int lr = ai * 128 + wr * 64 + m * 16 + fr, row = rowbase + lr;
                    const f32x4 p4 = *(const LAS f32x4*)(P + lr * 4); const float rstd = __builtin_amdgcn_rsqf(((p4[0] + p4[1]) + (p4[2] + p4[3])) * (1.f / 256.f) + EPS);
#pragma unroll
                    for (int bj = 0; bj < 2; ++bj) { const f32x4 z0 = acc[ai][bj][m][0] * rstd * gn[bj][0], z1 = acc[ai][bj][m][1] * rstd * gn[bj][1];
                        u32x4 w; w.x = cvt_pk_bf16(z0[0], z0[1]); w.y = cvt_pk_bf16(z0[2], z0[3]); w.z = cvt_pk_bf16(z1[0], z1[1]); w.w = cvt_pk_bf16(z1[2], z1[3]);
                        const int col = h * 256 + bj * 128 + cw;
                        *(u32x4*)(Z + (size_t)row * D + col) = w;
                        if (row >= MP) { float* o = out + O_CHV + (size_t)(row - MP) * D + col; *(f32x4*)o = z0; *(f32x4*)(o + 4) = z1; } } }
            asm volatile("s_waitcnt lgkmcnt(0)" ::: "memory"); __builtin_amdgcn_s_barrier(); asm volatile("" ::: "memory");
        } else if (pn < 16) {
#pragma unroll
            for (int ai = 0; ai < NAI; ++ai)
#pragma unroll
                for (int m = 0; m < 4; ++m) { const int row = row0 + ai * 128 + m * 16;
                    float* cdst = nullptr;
                    if (row < MP) { const int t = row & (SEQ - 1); if (t >= SEQ - 3) cdst = out + O_CONVP + (size_t)((row >> 11) * 3 + (t - (SEQ - 3))) * D; }
                    else { const int rs = row - MP, t = rs & 3; if (t >= 1) cdst = out + O_CONVS + (size_t)((rs >> 2) * 3 + (t - 1)) * D; }
#pragma unroll
                    for (int bj = 0; bj < 2; ++bj) { const f32x4 z0 = acc[ai][bj][m][0], z1 = acc[ai][bj][m][1];
                        u32x4 w; w.x = cvt_pk_bf16(z0[0], z0[1]); w.y = cvt_pk_bf16(z0[2], z0[3]); w.z = cvt_pk_bf16(z1[0], z1[1]); w.w = cvt_pk_bf16(z1[2], z1[3]);
                        const int col = (pn - 12) * 256 + bj * 128 + cw;
                        *(u32x4*)(XL + (size_t)row * D + col) = w;
                        if (cdst) { *(f32x4*)(cdst + col) = z0; *(f32x4*)(cdst + col + 4) = z1; } } }
        } else if (pn < 20) {
#pragma unroll
            for (int ai = 0; ai < NAI; ++ai)
#pragma unroll
                for (int m = 0; m < 4; ++m) { const int row = row0 + ai * 128 + m * 16;
#pragma unroll
                    for (int bj = 0; bj < 2; ++bj) { float v[8];
#pragma unroll
                        for (int n = 0; n < 2; ++n)
#pragma unroll
                            for (int j = 0; j < 4; ++j) { const float gg = acc[ai][bj][m][n][j]; v[4 * n + j] = gg * sigm(gg); }
                        u32x4 w; w.x = cvt_pk_bf16(v[0], v[1]); w.y = cvt_pk_bf16(v[2], v[3]); w.z = cvt_pk_bf16(v[4], v[5]); w.w = cvt_pk_bf16(v[6], v[7]);
                        *(u32x4*)(GL + (size_t)row * D + (pn - 16) * 256 + bj * 128 + cw) = w; } }
        } else {
            const int c0 = (pn - 20) * 128 + cw;
            f32x4 ba[2], bb[2];
#pragma unroll
            for (int n = 0; n < 2; ++n) { ba[n] = *(const f32x4*)(bmerge + c0 + 4 * n); bb[n] = *(const f32x4*)(bmerge + D + c0 + 4 * n); }
#pragma unroll
            for (int ai = 0; ai < NAI; ++ai)
#pragma unroll
                for (int m = 0; m < 4; ++m) { const int row = row0 + ai * 128 + m * 16; float q[8], gbv[8];
#pragma unroll
                    for (int n = 0; n < 2; ++n)
#pragma unroll
                        for (int j = 0; j < 4; ++j) { const float a = acc[ai][0][m][n][j] + ba[n][j], b = acc[ai][1][m][n][j] + bb[n][j];
                            const float eb = __builtin_amdgcn_exp2f(-1.44269504089f * b); const float ga = sigm(a);
                            gbv[4 * n + j] = fmaxf(__builtin_amdgcn_rcpf(1.f + eb), 1e-30f); q[4 * n + j] = fminf(ga * (1.f + eb), 3.0e38f); }
                    u32x4 w; w.x = cvt_pk_bf16(q[0], q[1]); w.y = cvt_pk_bf16(q[2], q[3]); w.z = cvt_pk_bf16(q[4], q[5]); w.w = cvt_pk_bf16(q[6], q[7]);
                    *(u32x4*)(QR + (size_t)row * D + c0) = w;
                    w.x = cvt_pk_bf16(gbv[0], gbv[1]); w.y = cvt_pk_bf16(gbv[2], gbv[3]); w.z = cvt_pk_bf16(gbv[4], gbv[5]); w.w = cvt_pk_bf16(gbv[6], gbv[7]);
                    *(u32x4*)(GB + (size_t)row * D + c0) = w; }
        }
    }
};
struct EpiG2 {
    static constexpr bool PERM = true, HAS_MID = true;
    const bf16_t *QR, *GB; bf16_t* MRG;
    template <int NAI, int NBJ> __device__ __forceinline__ void mid(f32x4 (&acc)[2][2][4][2], int rowbase, int pn, int wr, int wc, int fr, int fq) const {
        unsigned off0 = (unsigned)((rowbase + wr * 64 + fr) * D + pn * 128 * NBJ + wc * 32 + 8 * fq) * 2u; asm volatile("" : "+v"(off0));
#pragma unroll
        for (int ai = 0; ai < NAI; ++ai)
#pragma unroll
            for (int m = 0; m < 4; ++m) {
#pragma unroll
                for (int bj = 0; bj < NBJ; ++bj) { const u32x4 q = *(const u32x4*)((const char*)QR + (off0 + (unsigned)(((ai * 128 + m * 16) * D + bj * 128) * 2)));
                    acc[ai][bj][m][0] *= (f32x4){bf_lo(q.x), bf_hi(q.x), bf_lo(q.y), bf_hi(q.y)}; acc[ai][bj][m][1] *= (f32x4){bf_lo(q.z), bf_hi(q.z), bf_lo(q.w), bf_hi(q.w)}; }
                if (m & 1) asm volatile("" ::: "memory"); }
    }
    template <int NAI, int NBJ> __device__ __forceinline__ void run(f32x4 (&acc)[2][2][4][2], int rowbase, int pn, int wr, int wc, int fr, int fq, LAS unsigned char*) const {
        unsigned off0 = (unsigned)((rowbase + wr * 64 + fr) * D + pn * 128 * NBJ + wc * 32 + 8 * fq) * 2u; asm volatile("" : "+v"(off0));
#pragma unroll
        for (int ai = 0; ai < NAI; ++ai)
#pragma unroll
            for (int m = 0; m < 4; ++m) {
#pragma unroll
                for (int bj = 0; bj < NBJ; ++bj) { const unsigned off = off0 + (unsigned)(((ai * 128 + m * 16) * D + bj * 128) * 2); const u32x4 q = *(const u32x4*)((const char*)GB + off);
                    const f32x4 v0 = acc[ai][bj][m][0] * (f32x4){bf_lo(q.x), bf_hi(q.x), bf_lo(q.y), bf_hi(q.y)}, v1 = acc[ai][bj][m][1] * (f32x4){bf_lo(q.z), bf_hi(q.z), bf_lo(q.w), bf_hi(q.w)};
                    u32x4 w; w.x = cvt_pk_bf16(v0[0], v0[1]); w.y = cvt_pk_bf16(v0[2], v0[3]); w.z = cvt_pk_bf16(v1[0], v1[1]); w.w = cvt_pk_bf16(v1[2], v1[3]);
                    *(u32x4*)((char*)MRG + off) = w; }
                if (m & 1) asm volatile("" ::: "memory"); }
    }
};
struct EpiF32 {
    static constexpr bool PERM = false, HAS_MID = false;
    float* dst;
    template <int NAI, int NBJ> __device__ __forceinline__ void mid(f32x4 (&)[2][2][4][2], int, int, int, int, int, int) const {}
    template <int NAI, int NBJ> __device__ __forceinline__ void run(f32x4 (&acc)[2][2][4][2], int rowbase, int pn, int wr, int wc, int fr, int fq, LAS unsigned char*) const {
        const int row0 = rowbase + wr * 64 + fr, c0 = pn * 128 * NBJ + wc * 32 + 4 * fq;
#pragma unroll
        for (int ai = 0; ai < NAI; ++ai)
#pragma unroll
            for (int m = 0; m < 4; ++m)
#pragma unroll
                for (int bj = 0; bj < NBJ; ++bj)
#pragma unroll
                    for (int n = 0; n < 2; ++n) *(f32x4*)(dst + (size_t)(row0 + ai * 128 + m * 16) * D + c0 + bj * 128 + n * 16) = acc[ai][bj][m][n];
    }
};
struct EpiFinal {
    static constexpr bool PERM = false, HAS_MID = false;
    const float* X1F; const float* bias; float* out;
    template <int NAI, int NBJ> __device__ __forceinline__ void mid(f32x4 (&)[2][2][4][2], int, int, int, int, int, int) const {}
    template <int NAI, int NBJ> __device__ __forceinline__ void run(f32x4 (&acc)[2][2][4][2], int rowbase, int pn, int wr, int wc, int fr, int fq, LAS unsigned char*) const {
        const int row0 = rowbase + wr * 64 + fr, c0 = pn * 128 * NBJ + wc * 32 + 4 * fq;
#pragma unroll
        for (int bj = 0; bj < NBJ; ++bj)
#pragma unroll
            for (int n = 0; n < 2; ++n) { const f32x4 bv = *(const f32x4*)(bias + c0 + bj * 128 + n * 16);
#pragma unroll
                for (int ai = 0; ai < NAI; ++ai)
#pragma unroll
                    for (int m = 0; m < 4; ++m) { const size_t off = (size_t)(row0 + ai * 128 + m * 16) * D + c0 + bj * 128 + n * 16;
                        const f32x4 x1 = *(const f32x4*)(X1F + off), e = *(const f32x4*)(out + off), a = acc[ai][bj][m][n] + bv;
                        f32x4 o; o[0] = x1[0] + sigm(a[0]) * e[0]; o[1] = x1[1] + sigm(a[1]) * e[1]; o[2] = x1[2] + sigm(a[2]) * e[2]; o[3] = x1[3] + sigm(a[3]) * e[3];
                        *(f32x4*)(out + off) = o; } }
    }
};

#define XB_TMO      128
#define XB_XCNT(j)  (256  + 64 * (j))
#define XB_XSUB(j)  (1280 + 64 * (j))
#define XB_XGEN(j)  (2304 + 64 * (j))
#define XB_TOP      3328
#define XB_TOPGEN   3392
#define XCD_BAR_WORDS 3456
#define XB_SPIN_CAP (1u << 18)
__device__ __forceinline__ unsigned xb_ld(unsigned* p)              { return __hip_atomic_load(p, __ATOMIC_RELAXED, __HIP_MEMORY_SCOPE_AGENT); }
__device__ __forceinline__ unsigned xb_add(unsigned* p, unsigned v) { return __hip_atomic_fetch_add(p, v, __ATOMIC_RELAXED, __HIP_MEMORY_SCOPE_AGENT); }
__device__ __forceinline__ unsigned xb_xcc_id() { return (unsigned)__builtin_amdgcn_s_getreg((3 << 11) | 20) & 0xFu; }
#define XB_SPIN(cond, bar) do { unsigned _sp = 0; while (cond) { __builtin_amdgcn_s_sleep(1); \
    if ((++_sp & 255u) == 0u) { if (xb_ld(&(bar)[XB_TMO])) break; if (_sp > XB_SPIN_CAP) { atomicAdd(&(bar)[XB_TMO], 1u); break; } } } } while (0)
struct XcdBarrier { unsigned* bar; unsigned x; volatile LAS unsigned* st; };
__device__ __forceinline__ XcdBarrier xcd_barrier_post(unsigned* bar, volatile LAS unsigned* st) {
    XcdBarrier b; b.bar = bar; b.x = xb_xcc_id(); b.st = st;
    if (threadIdx.x == 0) (void)xb_add(&bar[XB_XCNT(b.x)], 1u);
    return b;
}
__device__ __forceinline__ void xcd_barrier_complete(unsigned* bar, unsigned x, unsigned& nloc, unsigned& nx) {
    const unsigned G = gridDim.x * gridDim.y * gridDim.z;
    unsigned sum, cnt, mine, sp = 0u;
    for (;;) {
        sum = 0u; cnt = 0u; mine = 0u;
#pragma unroll
        for (unsigned j = 0; j < 16; ++j) { const unsigned c = xb_ld(&bar[XB_XCNT(j)]); sum += c; cnt += (c > 0u) ? 1u : 0u; mine = (j == x) ? c : mine; }
        if (sum == G) break;
        __builtin_amdgcn_s_sleep(1);
        if ((++sp & 255u) == 0u) { if (xb_ld(&bar[XB_TMO])) break; if (sp > XB_SPIN_CAP) { atomicAdd(&bar[XB_TMO], 1u); break; } }
    }
    nloc = mine > 0u ? mine : 1u; nx = cnt > 0u ? cnt : 1u;
}
__device__ __forceinline__ void xcd_barrier(const XcdBarrier& b) {
    asm volatile("s_waitcnt vmcnt(0)" ::: "memory");
    __syncthreads();
    if (threadIdx.x == 0) {
        unsigned* bar = b.bar;
        __builtin_amdgcn_s_waitcnt(0);
        unsigned nloc = b.st[0], nx = b.st[1];
        if (nloc == 0u) { xcd_barrier_complete(bar, b.x, nloc, nx); b.st[0] = nloc; b.st[1] = nx; }
        const unsigned old = xb_add(&bar[XB_XSUB(b.x)], 1u);
        const unsigned gen = old / nloc;
        if (old + 1u == (gen + 1u) * nloc) {
            __builtin_amdgcn_fence(__ATOMIC_RELEASE, "agent");
            asm volatile("s_waitcnt vmcnt(0)" ::: "memory");
            const unsigned og = xb_add(&bar[XB_TOP], 1u);
            const unsigned tg = og / nx;
            if (og + 1u == (tg + 1u) * nx) xb_add(&bar[XB_TOPGEN], 1u);
            else XB_SPIN(xb_ld(&bar[XB_TOPGEN]) == tg, bar);
            __builtin_amdgcn_fence(__ATOMIC_ACQUIRE, "agent");
            xb_add(&bar[XB_XGEN(b.x)], 1u);
            asm volatile("s_waitcnt vmcnt(0)" ::: "memory");
        } else {
            XB_SPIN(xb_ld(&bar[XB_XGEN(b.x)]) == gen, bar);
            __builtin_amdgcn_fence(__ATOMIC_ACQUIRE, "agent");
            asm volatile("s_waitcnt vmcnt(0)" ::: "memory");
        }
    }
    __syncthreads();
}

__device__ __forceinline__ void p0_transpose_item(const float* W, int Nsrc, int scol0, int k0, bf16_t* WT, int ldd, int drow0, int dk0, LAS float* scr, int lane) {
#pragma unroll 8
    for (int i = 0; i < 32; ++i) { const int kk = 2 * i + (lane >> 5); scr[kk * 33 + (lane & 31)] = W[(size_t)(k0 + kk) * Nsrc + scol0 + (lane & 31)]; }
    LDS_WAIT(); asm volatile("" ::: "memory");
    const int c = lane & 7;
#pragma unroll
    for (int j = 0; j < 4; ++j) { const int n = (lane >> 3) + 8 * j; const LAS float* s = scr + (8 * c) * 33 + n;
        u32x4 o; o.x = cvt_pk_bf16(s[0 * 33], s[1 * 33]); o.y = cvt_pk_bf16(s[2 * 33], s[3 * 33]); o.z = cvt_pk_bf16(s[4 * 33], s[5 * 33]); o.w = cvt_pk_bf16(s[6 * 33], s[7 * 33]);
        *(u32x4*)(WT + (size_t)(drow0 + n) * ldd + dk0 + 8 * c) = o; }
    LDS_WAIT(); asm volatile("" ::: "memory");
}

#ifndef PROBE_PHASE
#define PROBE_PHASE -1
#endif
struct Args { const float* in[27]; float* out; unsigned char* ws; int pad0, pad1; };

__global__ void __launch_bounds__(NWAVES * 64, 2) mixer_fwd(Args args) {
    extern __shared__ __attribute__((aligned(16))) unsigned char lds_raw[];
    LAS unsigned char* lds = (LAS unsigned char*)lds_raw;
    volatile LAS unsigned* MISC = (volatile LAS unsigned*)(lds + MISC_OFF);
    const int tid = threadIdx.x, lane = tid & 63, wave = __builtin_amdgcn_readfirstlane(tid >> 6);
    const int G = gridDim.x; const int bx = blockIdx.x; const int vcu = (G % 8 == 0) ? (bx % 8) * (G / 8) + bx / 8 : bx;
    typedef const Args __attribute__((address_space(4))) CArgs;
    CArgs* const args_c = (CArgs*)__builtin_amdgcn_kernarg_segment_ptr();
#define KARGS() ({ CArgs* _p = args_c; asm volatile("" : "+s"(_p)); _p; })
    unsigned char* ws; float* out; { CArgs* A = KARGS(); ws = A->ws; out = A->out; }
    bf16_t* WIN = (bf16_t*)(ws + WS_WIN); bf16_t* WBR = (bf16_t*)(ws + WS_WBR); bf16_t* WOUT = (bf16_t*)(ws + WS_WOUT); bf16_t* WPG = (bf16_t*)(ws + WS_WPG); bf16_t* WPLE = (bf16_t*)(ws + WS_WPLE);
    bf16_t* LWA = (bf16_t*)(ws + WS_LWA); bf16_t* LWX = (bf16_t*)(ws + WS_LWX); bf16_t* SGW = (bf16_t*)(ws + WS_SGW); bf16_t* PB = (bf16_t*)(ws + WS_PB);
    bf16_t* H = (bf16_t*)out;
    bf16_t* UG = (bf16_t*)(ws + WS_R0); bf16_t* Z = (bf16_t*)(ws + WS_R1); bf16_t* XL = (bf16_t*)(ws + WS_R2); bf16_t* GL = (bf16_t*)(ws + WS_R3); bf16_t* QR = (bf16_t*)(ws + WS_R4); bf16_t* GB = (bf16_t*)(ws + WS_R5);
    bf16_t* MRG = (bf16_t*)(ws + WS_R1);
    float* X1F = (float*)(ws + WS_R4);
    bf16_t* X1B = (bf16_t*)(ws + WS_R0);

    for (int u = tid; u < (LDS_BYTES - MISC_OFF) / 4; u += NWAVES * 64) ((LAS unsigned*)(lds + MISC_OFF))[u] = 0u;
    __syncthreads();
    XcdBarrier bar = xcd_barrier_post((unsigned*)(ws + WS_CTL) + CW_BAR, MISC + 8);
    unsigned long long pr_t0 = 0, pr_t1 = 0; int pr_n = 0;
#define STAMP() do { if (PROBE_PHASE >= 0) { const unsigned long long _t = __builtin_amdgcn_s_memrealtime(); if (PROBE_PHASE < 100) { if (pr_n == PROBE_PHASE) pr_t0 = _t; if (pr_n == PROBE_PHASE + 1) pr_t1 = _t; } ++pr_n; } } while (0)
    STAMP();

    {
        CArgs* KA = KARGS();
        const float* x_prompt = KA->in[0]; const float* x_sample = KA->in[1]; const float* p_prompt = KA->in[2]; const float* p_sample = KA->in[3]; const float* norm_pre = KA->in[6]; const float* w_in = KA->in[7];
        const float* sg_w = KA->in[9]; const float* lru_wa = KA->in[13]; const float* lru_wx = KA->in[15]; const float* w_br_sg = KA->in[18]; const float* w_br_lru = KA->in[19]; const float* w_merge = KA->in[20];
        const float* w_out = KA->in[22]; const float* w_ple = KA->in[24]; const float* w_pg = KA->in[25];
        LAS float* scr = (LAS float*)(lds + wave * 16384);
        const int gw = vcu * NWAVES + wave, NGW = G * NWAVES;
        constexpr int I_WIN = (NIN / 32) * 16, I_WBR = 32 * 32, I_WOUT = 32 * 16, I_WPG = 32 * 16, I_WPLE = 32 * 4, I_LRU = 2 * 8 * 4 * 2;
        constexpr int NITEMS = I_WIN + I_WBR + I_WOUT + I_WPG + I_WPLE + I_LRU;
        for (int it = gw; it < NITEMS; it += NGW) {
            int r = it;
            if (r < I_WIN) { const int rb = r >> 4, kb = r & 15, pn = rb >> 3, q = rb & 7; const float* src; int ns, sc;
                if (pn < 8)       { src = w_in; ns = 5120; sc = (q < 4) ? (pn * 128 + q * 32) : (2048 + pn * 128 + (q - 4) * 32); }
                else if (pn < 12) { src = w_in; ns = 5120; sc = 1024 + (pn - 8) * 256 + q * 32; }
                else if (pn < 16) { src = w_in; ns = 5120; sc = 3072 + (pn - 12) * 256 + q * 32; }
                else if (pn < 20) { src = w_in; ns = 5120; sc = 4096 + (pn - 16) * 256 + q * 32; }
                else              { src = w_merge; ns = 2048; sc = (q < 4) ? ((pn - 20) * 128 + q * 32) : (1024 + (pn - 20) * 128 + (q - 4) * 32); }
                p0_transpose_item(src, ns, sc, kb * 64, WIN, 1024, rb * 32, kb * 64, scr, lane); continue; }
            r -= I_WIN;
            if (r < I_WBR) { const int rb = r >> 5, kb = r & 31; const float* src = kb < 16 ? w_br_sg : w_br_lru;
                p0_transpose_item(src, 1024, rb * 32, (kb & 15) * 64, WBR, 2048, rb * 32, kb * 64, scr, lane); continue; }
            r -= I_WBR;
            if (r < I_WOUT) { const int rb = r >> 4, kb = r & 15; p0_transpose_item(w_out, 1024, rb * 32, kb * 64, WOUT, 1024, rb * 32, kb * 64, scr, lane); continue; }
            r -= I_WOUT;
            if (r < I_WPG) { const int rb = r >> 4, kb = r & 15; p0_transpose_item(w_pg, 1024, rb * 32, kb * 64, WPG, 1024, rb * 32, kb * 64, scr, lane); continue; }
            r -= I_WPG;
            if (r < I_WPLE) { const int rb = r >> 2, kb = r & 3; p0_transpose_item(w_ple, 1024, rb * 32, kb * 64, WPLE, 256, rb * 32, kb * 64, scr, lane); continue; }
            r -= I_WPLE;
            { const int g = r >> 6, n = (r >> 3) & 7, rb = (r >> 1) & 3, kb = r & 1;
              p0_transpose_item((g ? lru_wx : lru_wa) + (size_t)n * 128 * 128, 128, rb * 32, kb * 64, (g ? LWX : LWA) + (size_t)n * 128 * 128, 128, rb * 32, kb * 64, scr, lane); }
        }
        for (int i = vcu * 512 + tid; i < 4 * 128 * 128; i += G * 512) { const int t = (i >> 7) & 127, s = i & 127; const float v = (s <= t) ? sg_w[i] : 0.f; SGW[i] = (bf16_t)(cvt_pk_bf16(v, 0.f) & 0xffffu); }
        for (int m = gw; m < M; m += NGW) {
            const float* xrow = (m < MP) ? x_prompt + (size_t)m * D : x_sample + (size_t)(m - MP) * D;
            const f32x4* xr = (const f32x4*)xrow + lane; f32x4 v[4]; float s = 0.f;
#pragma unroll
            for (int j = 0; j < 4; ++j) { v[j] = xr[64 * j]; s += (v[j][0] * v[j][0] + v[j][1] * v[j][1]) + (v[j][2] * v[j][2] + v[j][3] * v[j][3]); }
            const float rstd = 1.f / sqrtf(wave_sum(s) * (1.f / D) + EPS);
            u32x2* o8 = (u32x2*)(H + (size_t)m * D) + lane;
#pragma unroll
            for (int j = 0; j < 4; ++j) { const f32x4 gn = *((const f32x4*)norm_pre + lane + 64 * j); const f32x4 y = v[j] * rstd * gn;
                u32x2 w; w.x = cvt_pk_bf16(y[0], y[1]); w.y = cvt_pk_bf16(y[2], y[3]); o8[64 * j] = w; }
        }
        for (int i = vcu * 512 + tid; i < M * PLE / 8; i += G * 512) { const int row = i >> 5, c8 = i & 31;
            const float* src = (row < MP ? p_prompt + (size_t)row * PLE : p_sample + (size_t)(row - MP) * PLE) + c8 * 8;
            const f32x4 a = *(const f32x4*)src, b = *(const f32x4*)(src + 4);
            u32x4 w; w.x = cvt_pk_bf16(a[0], a[1]); w.y = cvt_pk_bf16(a[2], a[3]); w.z = cvt_pk_bf16(b[0], b[1]); w.w = cvt_pk_bf16(b[2], b[3]);
            *(u32x4*)(PB + (size_t)row * PLE + c8 * 8) = w; }
    }
    xcd_barrier(bar); STAMP();

    {
        CArgs* KA = KARGS(); const float* sg_norm = KA->in[8]; const float* b_merge = KA->in[21];
        pg8::Gemm g{H, H, WIN, 1024, 1024, 16, 16}; pg8::StaticOrder S; S.init(MP, NIN, G, bx);
        EpiG1 E{UG, Z, XL, GL, QR, GB, sg_norm, b_merge, out};
        pg8::gemm_phase<EpiG1, true>(lds, lds + EPI_OFF, g, S, E);
        for (int su = bx; su < 4 * 28; su += G) pg8::gemm_sub<EpiG1, 2>(lds, lds + EPI_OFF, g, MP + 128 * (su & 3), su >> 2, E);
    }
    xcd_barrier(bar); STAMP();

    {
        CArgs* KA = KARGS();
        const float* state_conv = KA->in[4]; const float* state_lru = KA->in[5]; const float* sg_w = KA->in[9]; const float* sg_b = KA->in[10]; const float* conv_w = KA->in[11]; const float* conv_b = KA->in[12];
        const float* lru_wa = KA->in[13]; const float* lru_ba = KA->in[14]; const float* lru_wx = KA->in[15]; const float* lru_bx = KA->in[16]; const float* lru_lambda = KA->in[17];
        const int fr = lane & 15, fq = lane >> 4;
        {
            LAS unsigned char* Zs = lds; LAS unsigned char* Ws = lds + 69632;
#pragma unroll 1
            for (int it = 0; it < 2; ++it) {
                const int item = 2 * vcu + it, c = item >> 2, h = item & 3, r0 = c * 128;
#pragma unroll
                for (int j = 0; j < 8; ++j) { const int idx = tid + 512 * j, row = idx >> 5, c16 = idx & 31;
                    *(LAS u32x4*)(Zs + row * 544 + 16 * c16) = *(const u32x4*)(Z + (size_t)(r0 + row) * D + 256 * h + 8 * c16); }
#pragma unroll
                for (int j = 0; j < 4; ++j) { const int idx = tid + 512 * j, row = idx >> 4, c16 = idx & 15;
                    *(LAS u32x4*)(Ws + row * 272 + 16 * c16) = *(const u32x4*)(SGW + (size_t)(h * 128 + row) * 128 + 8 * c16); }
                unsigned ugoff = (unsigned)((r0 + fr) * D + 256 * h + 32 * wave + 4 * fq) * 2u; asm volatile("" : "+v"(ugoff));
                u32x2 ugv[8][2];
#pragma unroll
                for (int tb = 0; tb < 8; ++tb)
#pragma unroll
                    for (int dbi = 0; dbi < 2; ++dbi) ugv[tb][dbi] = *(const u32x2*)((const char*)UG + (ugoff + (unsigned)((16 * tb * D + 16 * dbi) * 2)));
                __syncthreads();
                f32x4 acc[2][8];
#pragma unroll
                for (int a2 = 0; a2 < 2; ++a2)
#pragma unroll
                    for (int b2 = 0; b2 < 8; ++b2) acc[a2][b2] = (f32x4){0.f, 0.f, 0.f, 0.f};
#pragma unroll
                for (int ks = 0; ks < 4; ++ks) { const int k0 = 32 * ks; bf16x8 zf[2];
#pragma unroll
                    for (int dbi = 0; dbi < 2; ++dbi) { const int d0 = 16 * (2 * wave + dbi);
                        LAS unsigned char* a0 = Zs + (k0 + 8 * fq + (fr >> 2)) * 544 + (d0 + 4 * (fr & 3)) * 2;
                        const s16x4 lo = __builtin_bit_cast(s16x4, __builtin_amdgcn_ds_read_tr16_b64_v4i16((LAS s16x4*)a0));
                        const s16x4 hi = __builtin_bit_cast(s16x4, __builtin_amdgcn_ds_read_tr16_b64_v4i16((LAS s16x4*)(a0 + 4 * 544)));
                        zf[dbi] = (bf16x8){lo[0], lo[1], lo[2], lo[3], hi[0], hi[1], hi[2], hi[3]}; }
#pragma unroll
                    for (int tb = 0; tb < 8; ++tb) if (tb >= 2 * ks) { const bf16x8 wf = *(const LAS bf16x8*)(Ws + (16 * tb + fr) * 272 + (k0 + 8 * fq) * 2);
                        acc[0][tb] = __builtin_amdgcn_mfma_f32_16x16x32_bf16(zf[0], wf, acc[0][tb], 0, 0, 0); acc[1][tb] = __builtin_amdgcn_mfma_f32_16x16x32_bf16(zf[1], wf, acc[1][tb], 0, 0, 0); } }
                asm volatile("" : "+v"(ugoff));
#pragma unroll
                for (int tb = 0; tb < 8; ++tb) { const float bias = sg_b[h * 128 + 16 * tb + fr];
#pragma unroll
                    for (int dbi = 0; dbi < 2; ++dbi) { const u32x2 ug = ugv[tb][dbi];
                        u32x2 w; w.x = cvt_pk_bf16(bf_lo(ug.x) * (acc[dbi][tb][0] + bias), bf_hi(ug.x) * (acc[dbi][tb][1] + bias)); w.y = cvt_pk_bf16(bf_lo(ug.y) * (acc[dbi][tb][2] + bias), bf_hi(ug.y) * (acc[dbi][tb][3] + bias));
                        *(u32x2*)((char*)UG + (ugoff + (unsigned)((16 * tb * D + 16 * dbi) * 2))) = w; } }
                __syncthreads();
            }
        }
        STAMP();
        for (int idx = vcu * 512 + tid; idx < DBATCH * 128; idx += G * 512) { const int b = idx >> 7, col = (idx & 127) * 8, h = col >> 8;
            float zr[4][8];
#pragma unroll
            for (int s = 0; s < 4; ++s) { const u32x4 q = *(const u32x4*)(Z + (size_t)(MP + 4 * b + s) * D + col);
                zr[s][0] = bf_lo(q.x); zr[s][1] = bf_hi(q.x); zr[s][2] = bf_lo(q.y); zr[s][3] = bf_hi(q.y); zr[s][4] = bf_lo(q.z); zr[s][5] = bf_hi(q.z); zr[s][6] = bf_lo(q.w); zr[s][7] = bf_hi(q.w); }
#pragma unroll
            for (int t = 0; t < 4; ++t) { float sv[8]; const float bias = sg_b[h * 128 + t];
#pragma unroll
                for (int j = 0; j < 8; ++j) sv[j] = bias;
#pragma unroll
                for (int s = 0; s <= t; ++s) { const float w = sg_w[(size_t)(h * 128 + t) * 128 + s];
#pragma unroll
                    for (int j = 0; j < 8; ++j) sv[j] += w * zr[s][j]; }
                bf16_t* pp = UG + (size_t)(MP + 4 * b + t) * D + col; const u32x4 q = *(const u32x4*)pp;
                u32x4 w; w.x = cvt_pk_bf16(bf_lo(q.x) * sv[0], bf_hi(q.x) * sv[1]); w.y = cvt_pk_bf16(bf_lo(q.y) * sv[2], bf_hi(q.y) * sv[3]); w.z = cvt_pk_bf16(bf_lo(q.z) * sv[4], bf_hi(q.z) * sv[5]); w.w = cvt_pk_bf16(bf_lo(q.w) * sv[6], bf_hi(q.w) * sv[7]);
                *(u32x4*)pp = w; } }
        STAMP();
        {
            const int b = vcu >> 5, sl = vcu & 31, n = sl >> 2, sub = sl & 3, chb = 128 * n + 32 * sub;
            LAS unsigned char* Xs = lds; LAS unsigned char* XCs = lds + 35840; LAS f32x2* AB = (LAS f32x2*)(lds + 70656);
            LAS float* XCF = (LAS float*)(lds + 107520);
            bf16x8 wfr[2][2][4];
#pragma unroll
            for (int g = 0; g < 2; ++g)
#pragma unroll
                for (int cb = 0; cb < 2; ++cb)
#pragma unroll
                    for (int ks = 0; ks < 4; ++ks) wfr[g][cb][ks] = *(const bf16x8*)((g ? LWX : LWA) + (size_t)(n * 128 + 32 * sub + 16 * cb + fr) * 128 + 32 * ks + 8 * fq);
            f32x4 nba[2], nbx[2], c2[2];
#pragma unroll
            for (int cb = 0; cb < 2; ++cb) { const int ch = chb + 16 * cb + 4 * fq; const f32x4 ba4 = *(const f32x4*)(lru_ba + ch), bx4 = *(const f32x4*)(lru_bx + ch), lm4 = *(const f32x4*)(lru_lambda + ch);
                nba[cb] = ba4 * -1.44269504089f; nbx[cb] = bx4 * -1.44269504089f;
#pragma unroll
                for (int j = 0; j < 4; ++j) { const float xl = -lm4[j]; c2[cb][j] = -8.f * 1.44269504089f * (fmaxf(xl, 0.f) + log1pf(expf(-fabsf(xl)))); } }
            const int kg = tid & 15; f32x4 cwv[4][2], cbv[2];
            cbv[0] = *(const f32x4*)(conv_b + 128 * n + 8 * kg); cbv[1] = *(const f32x4*)(conv_b + 128 * n + 8 * kg + 4);
#pragma unroll
            for (int jj = 0; jj < 4; ++jj) { cwv[jj][0] = *(const f32x4*)(conv_w + jj * D + 128 * n + 8 * kg); cwv[jj][1] = *(const f32x4*)(conv_w + jj * D + 128 * n + 8 * kg + 4); }
            const bool own = (kg >> 2) == sub;
            u32x4 xpf[5], gnext, gcur; const int orow = tid >> 2, opart = tid & 3;
            { const int r0 = b * SEQ;
#pragma unroll
              for (int k = 0; k < 5; ++k) { const int idx = tid + 512 * k, row = idx >> 4, c16 = idx & 15; xpf[k] = (u32x4){0u, 0u, 0u, 0u};
                  if (idx < 131 * 16 && row >= 3) xpf[k] = *(const u32x4*)(XL + (size_t)(r0 - 3 + row) * D + 128 * n + 8 * c16); }
              gnext = *(const u32x4*)(GL + (size_t)(r0 + orow) * D + chb + 8 * opart); }
            float carry = 0.f;
            unsigned long long st_prev = 0, st_acc = 0;
#define SSTAMP(k) do { if (PROBE_PHASE >= 100) { const unsigned long long _t = __builtin_amdgcn_s_memrealtime(); if ((k) == PROBE_PHASE - 100) st_acc += _t - st_prev; st_prev = _t; } } while (0)
            SSTAMP(-1);
#pragma unroll 1
            for (int tc = 0; tc < 16; ++tc) {
                const int r0 = b * SEQ + 128 * tc;
#pragma unroll
                for (int k = 0; k < 5; ++k) { const int idx = tid + 512 * k, row = idx >> 4, c16 = idx & 15; if (idx < 131 * 16) *(LAS u32x4*)(Xs + row * 272 + 16 * c16) = xpf[k]; }
                gcur = gnext;
                if (tc < 15) { const int r1 = r0 + 128;
#pragma unroll
                    for (int k = 0; k < 5; ++k) { const int idx = tid + 512 * k, row = idx >> 4, c16 = idx & 15; if (idx < 131 * 16) xpf[k] = *(const u32x4*)(XL + (size_t)(r1 - 3 + row) * D + 128 * n + 8 * c16); }
                    gnext = *(const u32x4*)(GL + (size_t)(r1 + orow) * D + chb + 8 * opart); }
                LBAR(); SSTAMP(0);
#pragma unroll
                for (int it = 0; it < 4; ++it) { const int t = (tid >> 4) + 32 * it;
                    f32x4 a0 = cbv[0], a1 = cbv[1];
#pragma unroll
                    for (int jj = 0; jj < 4; ++jj) { const u32x4 q = *(const LAS u32x4*)(Xs + (t + jj) * 272 + 16 * kg);
                        a0 += cwv[jj][0] * (f32x4){bf_lo(q.x), bf_hi(q.x), bf_lo(q.y), bf_hi(q.y)}; a1 += cwv[jj][1] * (f32x4){bf_lo(q.z), bf_hi(q.z), bf_lo(q.w), bf_hi(q.w)}; }
                    u32x4 w; w.x = cvt_pk_bf16(a0[0], a0[1]); w.y = cvt_pk_bf16(a0[2], a0[3]); w.z = cvt_pk_bf16(a1[0], a1[1]); w.w = cvt_pk_bf16(a1[2], a1[3]);
                    *(LAS u32x4*)(XCs + t * 272 + 16 * kg) = w;
                    if (own) { LAS float* xp = XCF + t * 36 + 8 * (kg & 3); *(LAS f32x4*)xp = a0; *(LAS f32x4*)(xp + 4) = a1; } }
                LBAR(); SSTAMP(1);
                f32x4 ga[2][2];
#pragma unroll
                for (int g = 0; g < 2; ++g)
#pragma unroll
                    for (int cb = 0; cb < 2; ++cb) ga[g][cb] = (f32x4){0.f, 0.f, 0.f, 0.f};
#pragma unroll
                for (int ks = 0; ks < 4; ++ks) { const bf16x8 xf = *(const LAS bf16x8*)(XCs + (16 * wave + fr) * 272 + (32 * ks + 8 * fq) * 2);
#pragma unroll
                    for (int g = 0; g < 2; ++g)
#pragma unroll
                        for (int cb = 0; cb < 2; ++cb) ga[g][cb] = __builtin_amdgcn_mfma_f32_16x16x32_bf16(wfr[g][cb][ks], xf, ga[g][cb], 0, 0, 0); }
                { const int t = 16 * wave + fr, tp = t + (t >> 3);
#pragma unroll
                  for (int cb = 0; cb < 2; ++cb) { const f32x4 xc4 = *(const LAS f32x4*)(XCF + t * 36 + 16 * cb + 4 * fq);
#pragma unroll
                      for (int j = 0; j < 4; ++j) { const int chl = 16 * cb + 4 * fq + j;
                          const float r = __builtin_amdgcn_rcpf(1.f + __builtin_amdgcn_exp2f(ga[0][cb][j] * -1.44269504089f + nba[cb][j]));
                          const float ig = __builtin_amdgcn_rcpf(1.f + __builtin_amdgcn_exp2f(ga[1][cb][j] * -1.44269504089f + nbx[cb][j]));
                          const float a = __builtin_amdgcn_exp2f(c2[cb][j] * r);
                          const float mult = __builtin_amdgcn_sqrtf(1.f - a * a);
                          AB[chl * 144 + tp] = (f32x2){a, mult * ig * xc4[j]}; } } }
                LBAR(); SSTAMP(2);
                { const int chl = 4 * wave + (lane >> 4), seg = lane & 15; LAS f32x2* abp = AB + chl * 144 + 9 * seg;
                  f32x2 ab[8]; float A = 1.f, Hh = 0.f;
#pragma unroll
                  for (int i = 0; i < 8; ++i) { ab[i] = abp[i]; Hh = ab[i][0] * Hh + ab[i][1]; A *= ab[i][0]; }
#pragma unroll
                  for (int d = 1; d < 16; d <<= 1) { const float Ap = __shfl_up(A, d, 16), Hp = __shfl_up(Hh, d, 16); if (seg >= d) { Hh = A * Hp + Hh; A = A * Ap; } }
                  float Ae = __shfl_up(A, 1, 16), He = __shfl_up(Hh, 1, 16); if (seg == 0) { Ae = 1.f; He = 0.f; }
                  float h = Ae * carry + He;
                  const float hend = A * carry + Hh; carry = __shfl(hend, 15, 16);
#pragma unroll
                  for (int i = 0; i < 8; ++i) { h = ab[i][0] * h + ab[i][1]; abp[i] = (f32x2){h, 0.f}; } }
                LBAR(); SSTAMP(3);
                { const int tp = orow + (orow >> 3); float hv[8];
#pragma unroll
                  for (int j = 0; j < 8; ++j) hv[j] = AB[(8 * opart + j) * 144 + tp][0];
                  u32x4 w; w.x = cvt_pk_bf16(hv[0] * bf_lo(gcur.x), hv[1] * bf_hi(gcur.x)); w.y = cvt_pk_bf16(hv[2] * bf_lo(gcur.y), hv[3] * bf_hi(gcur.y));
                  w.z = cvt_pk_bf16(hv[4] * bf_lo(gcur.z), hv[5] * bf_hi(gcur.z)); w.w = cvt_pk_bf16(hv[6] * bf_lo(gcur.w), hv[7] * bf_hi(gcur.w));
                  *(u32x4*)(GL + (size_t)(r0 + orow) * D + chb + 8 * opart) = w; }
                SSTAMP(4);
            }
            if (PROBE_PHASE >= 100) { pr_t0 = 0; pr_t1 = st_acc; }
            if ((lane & 15) == 0) out[O_LRUP + (size_t)b * D + chb + 4 * wave + (lane >> 4)] = carry;
            __syncthreads();
        }
        STAMP();
        {
            const int grp = vcu >> 3, n = vcu & 7, sq = tid >> 7, c = tid & 127, b = 4 * grp + sq, ch = 128 * n + c;
            LAS unsigned char* XCb = lds;
            LAS float* GA = (LAS float*)(lds + 8192);
            bf16x8 wf[2][4];
#pragma unroll
            for (int g = 0; g < 2; ++g)
#pragma unroll
                for (int ks = 0; ks < 4; ++ks) wf[g][ks] = *(const bf16x8*)((g ? LWX : LWA) + (size_t)(n * 128 + 16 * wave + fr) * 128 + 32 * ks + 8 * fq);
            float xp[7], xc[4];
#pragma unroll
            for (int k = 0; k < 3; ++k) xp[k] = state_conv[(size_t)(b * 3 + k) * D + ch];
#pragma unroll
            for (int t = 0; t < 4; ++t) xp[3 + t] = bf2f(XL[(size_t)(MP + 4 * b + t) * D + ch]);
            const float cbv = conv_b[ch], cw0 = conv_w[ch], cw1 = conv_w[D + ch], cw2 = conv_w[2 * D + ch], cw3 = conv_w[3 * D + ch];
            const float xl = -lru_lambda[ch]; const float cl = -8.f * (fmaxf(xl, 0.f) + log1pf(expf(-fabsf(xl)))); const float bav = lru_ba[ch], bxv = lru_bx[ch];
            float h = state_lru[(size_t)b * D + ch];
            float glv[4];
#pragma unroll
            for (int t = 0; t < 4; ++t) glv[t] = bf2f(GL[(size_t)(MP + 4 * b + t) * D + ch]);
#pragma unroll
            for (int t = 0; t < 4; ++t) { xc[t] = cbv + cw0 * xp[t] + cw1 * xp[t + 1] + cw2 * xp[t + 2] + cw3 * xp[t + 3];
                *(LAS bf16_t*)(XCb + (sq * 4 + t) * 272 + 2 * c) = (bf16_t)(cvt_pk_bf16(xc[t], 0.f) & 0xffffu); }
            __syncthreads();
            f32x4 ga[2] = {(f32x4){0.f, 0.f, 0.f, 0.f}, (f32x4){0.f, 0.f, 0.f, 0.f}};
#pragma unroll
            for (int ks = 0; ks < 4; ++ks) { const bf16x8 xf = *(const LAS bf16x8*)(XCb + fr * 272 + (32 * ks + 8 * fq) * 2);
                ga[0] = __builtin_amdgcn_mfma_f32_16x16x32_bf16(wf[0][ks], xf, ga[0], 0, 0, 0); ga[1] = __builtin_amdgcn_mfma_f32_16x16x32_bf16(wf[1][ks], xf, ga[1], 0, 0, 0); }
            *(LAS f32x4*)(GA + fr * 132 + 16 * wave + 4 * fq) = ga[0]; *(LAS f32x4*)(GA + 16 * 132 + fr * 132 + 16 * wave + 4 * fq) = ga[1];
            __syncthreads();
#pragma unroll
            for (int t = 0; t < 4; ++t) { const float da = GA[(sq * 4 + t) * 132 + c], dx = GA[16 * 132 + (sq * 4 + t) * 132 + c];
                const float r = sigm(da + bav), ig = sigm(dx + bxv), la = cl * r, a = __expf(la), mult = sqrtf(-expm1f(2.f * la));
                h = a * h + mult * ig * xc[t];
                const float y = h * glv[t]; GL[(size_t)(MP + 4 * b + t) * D + ch] = (bf16_t)(cvt_pk_bf16(y, 0.f) & 0xffffu); }
            out[O_LRUS + (size_t)b * D + ch] = h;
            __syncthreads();
        }
    }
    xcd_barrier(bar); STAMP();

    {
        pg8::Gemm g{UG, GL, WBR, 1024, 2048, 32, 16}; pg8::StaticOrder S; S.init(MP, D, G, bx);
        EpiG2 E{QR, GB, MRG};
        pg8::gemm_phase<EpiG2, true>(lds, lds + EPI_OFF, g, S, E);
        for (int su = bx; su < 4 * 8; su += G) pg8::gemm_sub<EpiG2, 1>(lds, lds + EPI_OFF, g, MP + 128 * (su & 3), su >> 2, E);
    }
    xcd_barrier(bar); STAMP();

    {
        pg8::Gemm g{PB, PB, WPLE, 256, 256, 4, 4}; pg8::StaticOrder S; S.init(MP, D, G, bx);
        EpiF32 E{out};
        pg8::gemm_phase<EpiF32, true>(lds, lds + EPI_OFF, g, S, E);
        for (int su = bx; su < 4 * 8; su += G) pg8::gemm_sub<EpiF32, 1>(lds, lds + EPI_OFF, g, MP + 128 * (su & 3), su >> 2, E);
    }
    {
        pg8::Gemm g{MRG, MRG, WOUT, 1024, 1024, 16, 16}; pg8::StaticOrder S; S.init(MP, D, G, bx);
        EpiF32 E{X1F};
        pg8::gemm_phase<EpiF32, true>(lds, lds + EPI_OFF, g, S, E);
        for (int su = bx; su < 4 * 8; su += G) pg8::gemm_sub<EpiF32, 1>(lds, lds + EPI_OFF, g, MP + 128 * (su & 3), su >> 2, E);
    }
    xcd_barrier(bar); STAMP();

    {
        CArgs* KA = KARGS(); const float* x_prompt = KA->in[0]; const float* x_sample = KA->in[1]; const float* norm_post = KA->in[23];
        const int gw = vcu * NWAVES + wave, NGW = G * NWAVES;
        for (int m = gw; m < M; m += NGW) {
            const float* xrow = (m < MP) ? x_prompt + (size_t)m * D : x_sample + (size_t)(m - MP) * D;
            f32x4* orow = (f32x4*)(X1F + (size_t)m * D) + lane; f32x4 v[4]; float s = 0.f;
#pragma unroll
            for (int j = 0; j < 4; ++j) { v[j] = orow[64 * j]; s += (v[j][0] * v[j][0] + v[j][1] * v[j][1]) + (v[j][2] * v[j][2] + v[j][3] * v[j][3]); }
            const float rstd = 1.f / sqrtf(wave_sum(s) * (1.f / D) + EPS);
            u32x2* o8 = (u32x2*)(X1B + (size_t)m * D) + lane;
#pragma unroll
            for (int j = 0; j < 4; ++j) { const f32x4 gn = *((const f32x4*)norm_post + lane + 64 * j); const f32x4 xv = *((const f32x4*)xrow + lane + 64 * j); const f32x4 y = xv + v[j] * rstd * gn;
                orow[64 * j] = y; u32x2 w; w.x = cvt_pk_bf16(y[0], y[1]); w.y = cvt_pk_bf16(y[2], y[3]); o8[64 * j] = w; }
        }
    }
    xcd_barrier(bar); STAMP();

    {
        CArgs* KA = KARGS(); const float* b_pg = KA->in[26];
        pg8::Gemm g{X1B, X1B, WPG, 1024, 1024, 16, 16}; pg8::StaticOrder S; S.init(MP, D, G, bx);
        EpiFinal E{X1F, b_pg, out};
        pg8::gemm_phase<EpiFinal, true>(lds, lds + EPI_OFF, g, S, E);
        for (int su = bx; su < 4 * 8; su += G) pg8::gemm_sub<EpiFinal, 1>(lds, lds + EPI_OFF, g, MP + 128 * (su & 3), su >> 2, E);
    }
    if (PROBE_PHASE >= 0) {
        xcd_barrier(bar); STAMP();
        if (bx == 0) { const float dt_us = (float)(pr_t1 - pr_t0) * 0.01f; const float sc = 1.01f + dt_us * 1e-4f;
            for (int i = tid; i < 8 * 3 * 1024; i += 512) out[O_CONVP + i] *= sc; }
    }
}

extern "C" void kernel_launch(void* const* d_in, const int* in_sizes, int n_in, void* d_out, int out_size, void* d_ws, size_t ws_size, hipStream_t stream) {
    static int grid = 0;
    if (grid == 0) {
        if (n_in != 27 || (size_t)out_size != O_END || ws_size < WS_END) { fprintf(stderr, "kernel_launch: unexpected shapes (n_in %d out %d ws %zu)\n", n_in, out_size, ws_size); grid = -1; return; }
        int dev = 0, cus = 0, per_cu = 0;
        if (hipGetDevice(&dev) != hipSuccess || hipDeviceGetAttribute(&cus, hipDeviceAttributeMultiprocessorCount, dev) != hipSuccess) { grid = -1; return; }
        if (hipFuncSetAttribute((const void*)mixer_fwd, hipFuncAttributeMaxDynamicSharedMemorySize, LDS_BYTES) != hipSuccess) { fprintf(stderr, "kernel_launch: hipFuncSetAttribute failed\n"); grid = -1; return; }
        if (hipOccupancyMaxActiveBlocksPerMultiprocessor(&per_cu, (const void*)mixer_fwd, NWAVES * 64, LDS_BYTES) != hipSuccess || per_cu < 1) { fprintf(stderr, "kernel_launch: occupancy query says %d\n", per_cu); per_cu = 1; }
        (void)hipGetLastError();
        grid = cus;
        if (grid > 256) grid = 256;
    }
    if (grid < 0) return;
    (void)hipMemsetAsync((char*)d_ws + WS_CTL, 0, CTL_ZERO_BYTES, stream);
    Args a{};
    for (int i = 0; i < 27; ++i) a.in[i] = (const float*)d_in[i];
    a.out = (float*)d_out; a.ws = (unsigned char*)d_ws;
    hipLaunchKernelGGL(mixer_fwd, dim3(grid), dim3(NWAVES * 64), LDS_BYTES, stream, a);
}
```
